# Optimizing an MI355X kernel written in HIP

```python
import math
import jax, jax.numpy as jnp
from jax import lax
import numpy as np

D_MODEL = 1024
BATCH = 4
SEQ = 4096
DEPTH = 4

D_MIX = D_MODEL
EPS = 1e-5
ATTN_HEADS = 4
ATTN_QK_DIM = 64
ATTN_V_DIM = 2 * ATTN_QK_DIM
ATTN_WIDTH = ATTN_HEADS * ATTN_V_DIM
Q_BLOCK = 128
ROPE_THETA = 500000.0
ROT_DIM = ATTN_QK_DIM // 4
SC_WIDTH = 256
SC_CONV = 3
SSD_HEADS = 4
SSD_HEAD_DIM = 64
SSD_WIDTH = SSD_HEADS * SSD_HEAD_DIM
SSD_GROUPS = 2
SSD_STATE = 128
SSD_HEADS_PER_GROUP = SSD_HEADS // SSD_GROUPS
SSD_CONV = 3
SSD_CHUNK = 128
SSD_XBC = SSD_WIDTH + 2 * SSD_GROUPS * SSD_STATE
D_FF = 2816
FFN_CONV = 3

Q_COLS = ATTN_HEADS * 2 * ATTN_QK_DIM
K_COLS = Q_COLS
V_COLS = ATTN_WIDTH
_SEG = [Q_COLS, K_COLS, V_COLS, SC_WIDTH, SC_WIDTH, SC_WIDTH, SSD_WIDTH, SSD_XBC, SSD_HEADS, SSD_HEADS]
SPLITS = [int(v) for v in np.cumsum(_SEG)[:-1]]
IN_COLS = int(sum(_SEG))

kernel_name = "hymba_style_bidir_diffattn_shortconv_ssd"

F32 = jnp.float32


def rms_norm(x, g):
    xf = x.astype(F32)
    y = xf * lax.rsqrt(jnp.mean(xf * xf, axis=-1, keepdims=True) + EPS)
    return (y * g.astype(F32)).astype(x.dtype)


def conv_centered(t, w, bias=None):
    K = w.shape[0]
    pad = K // 2
    S = t.shape[1]
    tp = jnp.pad(t, ((0, 0), (pad, pad), (0, 0)))
    out = tp[:, 0:S] * w[0]
    for k in range(1, K):
        out = out + tp[:, k:k + S] * w[k]
    if bias is not None:
        out = out + bias
    return out


def partial_rotary(t, cos, sin):
    half = ROT_DIM // 2
    c = cos[:, :, None, None, :].astype(t.dtype)
    s = sin[:, :, None, None, :].astype(t.dtype)
    t1 = t[..., :half]
    t2 = t[..., half:ROT_DIM]
    return jnp.concatenate([t1 * c - t2 * s, t2 * c + t1 * s, t[..., ROT_DIM:]], axis=-1)


def diff_attention(q, k, v, lam, lam_init, subln_g):
    b, S, h, _, d = q.shape
    nq = S // Q_BLOCK
    scale = d ** -0.5
    qb = q.reshape(b, nq, Q_BLOCK, h, 2, d).transpose(1, 0, 2, 3, 4, 5)

    def block(qi):
        s = jnp.einsum('bqhcd,bkhcd->bhcqk', qi, k).astype(F32) * scale
        p = jax.nn.softmax(s, axis=-1)
        w = p[:, :, 0] - lam * p[:, :, 1]
        return jnp.einsum('bhqk,bkhe->bqhe', w.astype(v.dtype), v)

    o = lax.map(block, qb)
    o = o.transpose(1, 0, 2, 3, 4).reshape(b, S, h, ATTN_V_DIM)
    o = rms_norm(o, subln_g) * (1.0 - lam_init)
    return o.reshape(b, S, h * ATTN_V_DIM)


def ssd_scan(x, dt, A, Bm, Cm):
    b, S, h, p = x.shape
    n = Bm.shape[-1]
    c = S // SSD_CHUNK
    L = SSD_CHUNK
    xd = (x * dt[..., None]).reshape(b, c, L, h, p)
    a = (dt * A).reshape(b, c, L, h).transpose(0, 3, 1, 2)
    Bc = Bm.reshape(b, c, L, h, n)
    Cc = Cm.reshape(b, c, L, h, n)
    a_cs = jnp.cumsum(a, axis=-1)
    mask = jnp.tril(jnp.ones((L, L), dtype=bool))
    seg = a_cs[..., :, None] - a_cs[..., None, :]
    Lmat = jnp.where(mask, jnp.exp(jnp.where(mask, seg, 0.0)), 0.0)
    scores = jnp.einsum('bclhn,bcshn->bhcls', Cc, Bc) * Lmat
    y_diag = jnp.einsum('bhcls,bcshp->bclhp', scores, xd)
    decay_states = jnp.exp(a_cs[..., -1:] - a_cs)
    states = jnp.einsum('bclhn,bhcl,bclhp->bchpn', Bc, decay_states, xd)
    chunk_decay = jnp.exp(a_cs[..., -1])

    def step(hstate, inp):
        st, dec = inp
        return hstate * dec[..., None, None] + st, hstate

    h0 = jnp.zeros((b, h, p, n), dtype=states.dtype)
    _, prev = lax.scan(step, h0, (states.transpose(1, 0, 2, 3, 4), chunk_decay.transpose(2, 0, 1)))
    prev = prev.transpose(1, 0, 2, 3, 4)
    y_off = jnp.einsum('bclhn,bchpn,bhcl->bclhp', Cc, prev, jnp.exp(a_cs))
    return (y_diag + y_off).reshape(b, S, h, p)


def ssd_mixer(xbc, z, dt_f, dt_b, conv_w, conv_b, dt_bias, a_log, d_skip, norm_g):
    b, S, _ = xbc.shape
    xbc = jax.nn.silu(conv_centered(xbc, conv_w, conv_b))
    xs, Bm, Cm = jnp.split(xbc, [SSD_WIDTH, SSD_WIDTH + SSD_GROUPS * SSD_STATE], axis=-1)
    xs = xs.reshape(b, S, SSD_HEADS, SSD_HEAD_DIM).astype(F32)
    Bm = jnp.repeat(Bm.reshape(b, S, SSD_GROUPS, SSD_STATE), SSD_HEADS_PER_GROUP, axis=2).astype(F32)
    Cm = jnp.repeat(Cm.reshape(b, S, SSD_GROUPS, SSD_STATE), SSD_HEADS_PER_GROUP, axis=2).astype(F32)
    A = -jnp.exp(a_log.astype(F32))
    dtb = dt_bias.astype(F32)
    dtf = jax.nn.softplus(dt_f.astype(F32) + dtb[0])
    dtr = jax.nn.softplus(dt_b.astype(F32) + dtb[1])
    flip = lambda t: jnp.flip(t, axis=1)
    y_fwd = ssd_scan(xs, dtf, A[0], Bm, Cm)
    y_bwd = flip(ssd_scan(flip(xs), flip(dtr), A[1], flip(Bm), flip(Cm)))
    y = y_fwd + y_bwd + d_skip.astype(F32)[:, None] * xs
    y = y.reshape(b, S, SSD_WIDTH) * jax.nn.silu(z.astype(F32))
    gs = SSD_WIDTH // SSD_GROUPS
    y = rms_norm(y.reshape(b, S, SSD_GROUPS, gs), norm_g.reshape(SSD_GROUPS, gs))
    return y.reshape(b, S, SSD_WIDTH).astype(z.dtype)


def setup_inputs(seed: int = 0) -> dict:
    key = jax.random.key(seed)
    ks = jax.random.split(key, 24)
    nrm = lambda k, shape, s: jax.random.normal(k, shape, dtype=F32) * s
    x = jax.random.normal(ks[0], (BATCH, SEQ, D_MODEL), dtype=F32)
    offs = jax.random.randint(ks[1], (BATCH, 1), 0, 1024, dtype=jnp.int32)
    positions = (jnp.arange(SEQ, dtype=jnp.int32)[None, :] + offs).astype(jnp.int32)
    dt0 = jnp.exp(jax.random.uniform(ks[10], (DEPTH, 2, SSD_HEADS), minval=math.log(1e-3), maxval=math.log(1e-1)))
    return {
        "x": x,
        "positions": positions,
        "norm_mix_g": 1.0 + nrm(ks[2], (DEPTH, D_MODEL), 0.02),
        "w_in": nrm(ks[3], (DEPTH, D_MODEL, IN_COLS), D_MODEL ** -0.5),
        "lam_q1": nrm(ks[4], (DEPTH, ATTN_QK_DIM), 0.1),
        "lam_k1": nrm(ks[5], (DEPTH, ATTN_QK_DIM), 0.1),
        "lam_q2": nrm(ks[6], (DEPTH, ATTN_QK_DIM), 0.1),
        "lam_k2": nrm(ks[7], (DEPTH, ATTN_QK_DIM), 0.1),
        "subln_g": 1.0 + nrm(ks[8], (DEPTH, ATTN_V_DIM), 0.02),
        "sc_conv_w": nrm(ks[9], (DEPTH, SC_CONV, SC_WIDTH), SC_CONV ** -0.5),
        "ssd_conv_w": nrm(ks[11], (DEPTH, SSD_CONV, SSD_XBC), SSD_CONV ** -0.5),
        "ssd_conv_b": nrm(ks[12], (DEPTH, SSD_XBC), 0.02),
        "ssd_dt_bias": dt0 + jnp.log(-jnp.expm1(-dt0)),
        "ssd_a_log": jnp.log(jax.random.uniform(ks[13], (DEPTH, 2, SSD_HEADS), minval=1.0, maxval=16.0)),
        "ssd_d": 1.0 + nrm(ks[14], (DEPTH, SSD_HEADS), 0.02),
        "ssd_norm_g": 1.0 + nrm(ks[15], (DEPTH, SSD_WIDTH), 0.02),
        "w_out": nrm(ks[16], (DEPTH, D_MIX, D_MODEL), D_MIX ** -0.5),
        "norm_ffn_g": 1.0 + nrm(ks[17], (DEPTH, D_MODEL), 0.02),
        "w_up": nrm(ks[18], (DEPTH, D_MODEL, 2 * D_FF), D_MODEL ** -0.5),
        "ffn_conv_w": nrm(ks[19], (DEPTH, FFN_CONV, 2 * D_FF), FFN_CONV ** -0.5),
        "ffn_conv_b": nrm(ks[20], (DEPTH, 2 * D_FF), 0.02),
        "w_down": nrm(ks[21], (DEPTH, D_FF, D_MODEL), D_FF ** -0.5),
        "final_norm_g": 1.0 + nrm(ks[22], (D_MODEL,), 0.02),
    }


def reference(x, positions, norm_mix_g, w_in, lam_q1, lam_k1, lam_q2, lam_k2, subln_g, sc_conv_w,
              ssd_conv_w, ssd_conv_b, ssd_dt_bias, ssd_a_log, ssd_d, ssd_norm_g, w_out,
              norm_ffn_g, w_up, ffn_conv_w, ffn_conv_b, w_down, final_norm_g):
    b, S, _ = x.shape
    inv_freq = ROPE_THETA ** (-jnp.arange(0, ROT_DIM, 2, dtype=F32) / ROT_DIM)
    ang = positions.astype(F32)[..., None] * inv_freq
    cos, sin = jnp.cos(ang), jnp.sin(ang)

    for l in range(DEPTH):
        lam_init = 0.8 - 0.6 * math.exp(-0.3 * l)
        h = rms_norm(x, norm_mix_g[l])
        proj = h @ w_in[l]
        q, k, v, sc_b, sc_c, sc_h, z, xbc, dt_f, dt_b = jnp.split(proj, SPLITS, axis=-1)

        q = partial_rotary(q.reshape(b, S, ATTN_HEADS, 2, ATTN_QK_DIM), cos, sin)
        k = partial_rotary(k.reshape(b, S, ATTN_HEADS, 2, ATTN_QK_DIM), cos, sin)
        v = v.reshape(b, S, ATTN_HEADS, ATTN_V_DIM)
        lam = (jnp.exp(jnp.sum(lam_q1[l].astype(F32) * lam_k1[l].astype(F32)))
               - jnp.exp(jnp.sum(lam_q2[l].astype(F32) * lam_k2[l].astype(F32))) + lam_init)
        y_attn = diff_attention(q, k, v, lam, lam_init, subln_g[l])

        y_conv = sc_b * conv_centered(sc_c * sc_h, sc_conv_w[l])

        y_ssd = ssd_mixer(xbc, z, dt_f, dt_b, ssd_conv_w[l], ssd_conv_b[l], ssd_dt_bias[l],
                          ssd_a_log[l], ssd_d[l], ssd_norm_g[l])

        y = jnp.concatenate([y_attn, y_conv.astype(y_attn.dtype), y_ssd.astype(y_attn.dtype)], axis=-1)
        x = x + (y @ w_out[l]).astype(x.dtype)

        h = rms_norm(x, norm_ffn_g[l])
        u = conv_centered(h @ w_up[l], ffn_conv_w[l], ffn_conv_b[l])
        g, u = jnp.split(u, 2, axis=-1)
        x = x + ((jax.nn.silu(g) * u) @ w_down[l]).astype(x.dtype)

    return rms_norm(x, final_norm_g)
```

```cpp
#include <hip/hip_runtime.h>
#include <hip/hip_cooperative_groups.h>
#include <cstdio>
#include <cstdint>
namespace cg = cooperative_groups;
__device__ __forceinline__ float lx_get(float v, int lane, int o) { return __builtin_bit_cast(float, __builtin_amdgcn_ds_bpermute((lane ^ o) << 2, __builtin_bit_cast(int, v))); }
__device__ __forceinline__ float lx_sum32(float v) { const unsigned a = __builtin_bit_cast(unsigned, v); auto r = __builtin_amdgcn_permlane32_swap(a, a, false, false); const unsigned r0 = r[0], r1 = r[1]; return __builtin_bit_cast(float, r0) + __builtin_bit_cast(float, r1); }
__device__ __forceinline__ float lx_max32(float v) { const unsigned a = __builtin_bit_cast(unsigned, v); auto r = __builtin_amdgcn_permlane32_swap(a, a, false, false); const unsigned r0 = r[0], r1 = r[1]; return fmaxf(__builtin_bit_cast(float, r0), __builtin_bit_cast(float, r1)); }
#define LX_DPP(v, ctrl) __builtin_bit_cast(float, __builtin_amdgcn_update_dpp(0, __builtin_bit_cast(int, (v)), (ctrl), 0xf, 0xf, false))
__device__ __forceinline__ float wave_sum_l(float v, int lane) {
#pragma unroll
    for (int o = 1; o < 32; o <<= 1) v += lx_get(v, lane, o);
    return lx_sum32(v);
}
#define wave_sum(v) wave_sum_l((v), lane)

namespace pg8 {
#define PG8_LAS __attribute__((address_space(3)))
typedef unsigned short bf16_t;
typedef short bf16x8 __attribute__((ext_vector_type(8)));
typedef float f32x4 __attribute__((ext_vector_type(4)));
typedef unsigned u32x4 __attribute__((ext_vector_type(4)));
constexpr int BM = 256, BK = 64, HALF = 128, HTB = HALF * BK * 2  , STAGE_BYTES = 8 * HTB, NXCD = 8, WGM = 8;

__host__ __device__ __forceinline__ int lds_byte(int r, int c) { const int st = (r >> 4) * 2 + (c >> 5), rr = r & 15, cc = c & 31, ob = rr * 64 + cc * 2; return st * 1024 + (ob ^ (((ob >> 9) & 1) << 5)); }
__host__ __device__ __forceinline__ void stage_rc(int b, int& R, int& C) { const int st = b / 1024, sb = b % 1024, swz = sb ^ (((sb >> 9) & 1) << 5); R = (st >> 1) * 16 + swz / 64; C = (st & 1) * 32 + (swz % 64) / 2; }
__host__ __device__ __forceinline__ int perm32(int rho) { const int n = rho >> 4, i = rho & 15; return 8 * (i >> 2) + 4 * n + (i & 3); }

struct Unit { int pm, pn; };
struct Gemm { const bf16_t* A; const bf16_t* Bt; int M, N, K; };

struct StaticOrder {
    int nM, nN, nwg, G, c;
    __host__ __device__ void init(int M, int N, int G_, int c_) { nM = M / BM; nN = N / BM; nwg = nM * nN; G = G_; c = c_; }
    __host__ __device__ bool next(int i, Unit& u) const {
        const int L = i * G + c; if (L >= nwg) return false;
        int wgid = L; { const int q = nwg / NXCD, r = nwg % NXCD, xcd = wgid % NXCD, off = wgid / NXCD; wgid = (xcd < r ? xcd * (q + 1) : r * (q + 1) + (xcd - r) * q) + off; }
        const int nig = WGM * nN, gid = wgid / nig, fm = gid * WGM, gsz = (nM - fm) < WGM ? (nM - fm) : WGM;
        u.pm = fm + ((wgid % nig) % gsz); u.pn = (wgid % nig) / gsz; return true;
    }
    __device__ __forceinline__ void a_ready(const Unit&) const {}
    __device__ __forceinline__ void done(const Unit&) const {}
};

typedef unsigned u32x2 __attribute__((ext_vector_type(2)));
typedef float f32x2_t __attribute__((ext_vector_type(2))); typedef __bf16 bf16x2_t __attribute__((ext_vector_type(2)));
__device__ __forceinline__ unsigned cvtpk(float lo, float hi) { f32x2_t v = {lo, hi}; bf16x2_t b = __builtin_convertvector(v, bf16x2_t); return __builtin_bit_cast(unsigned, b); }
__device__ __forceinline__ u32x4 pack8(f32x4 a, f32x4 b) { u32x4 w; w.x = cvtpk(a[0], a[1]); w.y = cvtpk(a[2], a[3]); w.z = cvtpk(b[0], b[1]); w.w = cvtpk(b[2], b[3]); return w; }
constexpr float RMS_EPS = 1e-5f;
constexpr float QSCALE = 0.125f * 1.4426950408889634f;
__device__ __forceinline__ float rscale_row(const float* rss, int row, int fq, int lane) {
    const f32x4 v = *(const f32x4*)(rss + (size_t)row * 16 + 4 * fq);
    float s = (v[0] + v[1]) + (v[2] + v[3]);
    s += lx_get(s, lane, 16); s = lx_sum32(s);
    return __builtin_amdgcn_rsqf(s * (1.0f / 1024.0f) + RMS_EPS);
}
struct EpiIn {
    static constexpr bool PERM = true, AFTER_DRAIN = false;
    const float* rss; const float* cosT; const float* sinT; bf16_t* Q; bf16_t* K; bf16_t* V; bf16_t* P;
    __device__ __forceinline__ void operator()(const f32x4 (&acc)[2][2][4][2], const Unit& u, int wr, int wc, int fr, int fq) const {
        const int pn = u.pn, lane = fq * 16 + fr; bf16_t* dst; int ld, colt;
        if (pn < 2) { dst = Q; ld = 512; colt = pn * 256; } else if (pn < 4) { dst = K; ld = 512; colt = (pn - 2) * 256; }
        else if (pn < 6) { dst = V; ld = 512; colt = (pn - 4) * 256; } else { dst = P; ld = 1792; colt = (pn - 6) * 256; }
        const bool qk = pn < 4; const bool rot = qk && ((wc & 1) == 0) && (fq < 2);
        const int col0 = colt + wc * 32 + 8 * fq;
#pragma unroll
        for (int ai = 0; ai < 2; ++ai)
#pragma unroll
            for (int m = 0; m < 4; ++m) {
                const int row = u.pm * BM + ai * HALF + wr * 64 + m * 16 + fr;
                const float rs = rscale_row(rss, row, fq, lane);
                f32x4 c0 = {1.f, 1.f, 1.f, 1.f}, c1 = c0, s0 = {0.f, 0.f, 0.f, 0.f}, s1 = s0;
                if (qk) { c0 = *(const f32x4*)(cosT + (size_t)row * 8); c1 = *(const f32x4*)(cosT + (size_t)row * 8 + 4); s0 = *(const f32x4*)(sinT + (size_t)row * 8); s1 = *(const f32x4*)(sinT + (size_t)row * 8 + 4); }
#pragma unroll
                for (int bj = 0; bj < 2; ++bj) {
                    f32x4 v0 = acc[ai][bj][m][0] * rs, v1 = acc[ai][bj][m][1] * rs;
                    if (qk) {
                        f32x4 p0, p1;
#pragma unroll
                        for (int j = 0; j < 4; ++j) { p0[j] = lx_get(v0[j], lane, 16); p1[j] = lx_get(v1[j], lane, 16); }
                        if (rot) { if (fq == 0) { v0 = v0 * c0 - p0 * s0; v1 = v1 * c1 - p1 * s1; } else { v0 = v0 * c0 + p0 * s0; v1 = v1 * c1 + p1 * s1; } }
                    }
                    if (pn < 2) { v0 = v0 * QSCALE; v1 = v1 * QSCALE; }
                    *(u32x4*)(dst + (size_t)row * ld + col0 + bj * HALF) = pack8(v0, v1);
                }
                asm volatile("" ::: "memory");
            }
    }
};
struct EpiRes {
    static constexpr bool PERM = true, AFTER_DRAIN = false;
    bf16_t* xb; float* rss;
    __device__ __forceinline__ void operator()(const f32x4 (&acc)[2][2][4][2], const Unit& u, int wr, int wc, int fr, int fq) const {
        const int col0 = u.pn * BM + wc * 32 + 8 * fq, lane = fq * 16 + fr;
        u32x4 rb[2][2];
#define RES_LD(gi, buf) do { const size_t off_ = (size_t)(u.pm * BM + ((gi) >> 2) * HALF + wr * 64 + ((gi) & 3) * 16 + fr) * 1024 + col0; \
        rb[buf][0] = *(const u32x4*)(xb + off_); rb[buf][1] = *(const u32x4*)(xb + off_ + HALF); } while (0)
        RES_LD(0, 0);
#pragma unroll
        for (int gi = 0; gi < 8; ++gi) {
            const int ai = gi >> 2, m = gi & 3, buf = gi & 1;
            if (gi < 7) RES_LD(gi + 1, buf ^ 1);
            asm volatile("" ::: "memory");
            const int row = u.pm * BM + ai * HALF + wr * 64 + m * 16 + fr; float ss = 0.f;
#pragma unroll
            for (int bj = 0; bj < 2; ++bj) {
                const u32x4 r = rb[buf][bj];
                const f32x4 b0 = {__uint_as_float(r.x << 16), __uint_as_float(r.x & 0xffff0000u), __uint_as_float(r.y << 16), __uint_as_float(r.y & 0xffff0000u)};
                const f32x4 b1 = {__uint_as_float(r.z << 16), __uint_as_float(r.z & 0xffff0000u), __uint_as_float(r.w << 16), __uint_as_float(r.w & 0xffff0000u)};
                const f32x4 v0 = b0 + acc[ai][bj][m][0], v1 = b1 + acc[ai][bj][m][1];
                ss += (v0[0] * v0[0] + v0[1] * v0[1]) + (v0[2] * v0[2] + v0[3] * v0[3]) + (v1[0] * v1[0] + v1[1] * v1[1]) + (v1[2] * v1[2] + v1[3] * v1[3]);
                *(u32x4*)(xb + (size_t)row * 1024 + col0 + bj * HALF) = pack8(v0, v1);
            }
            ss += lx_get(ss, lane, 16); ss = lx_sum32(ss);
            if (fq == 0) rss[(size_t)row * 16 + 4 * u.pn + wc] = ss;
            asm volatile("" ::: "memory");
        }
#undef RES_LD
    }
};
struct EpiUpConv {
    static constexpr bool PERM = true, AFTER_DRAIN = false;
    const float* rss; const float* cw; const float* cb; bf16_t* A2; PG8_LAS float* wbuf; PG8_LAS float* cbuf;
    __device__ __forceinline__ static float unpk(unsigned w, int hi) { float r; if (hi) asm volatile("v_and_b32 %0, 0xffff0000, %1" : "=v"(r) : "v"(w)); else asm volatile("v_lshlrev_b32 %0, 16, %1" : "=v"(r) : "v"(w)); return r; }
    __device__ __forceinline__ static float unpk2(unsigned w, int hi) { return __builtin_bit_cast(float, hi ? (w & 0xffff0000u) : (w << 16)); }
    __device__ __forceinline__ static void xch8(const unsigned (&w)[8], unsigned csm4, unsigned (&pv)[8], unsigned (&nx)[8]) {
        asm volatile("ds_write_b32 %0, %1 offset:4\n\tds_write_b32 %0, %2 offset:68\n\tds_write_b32 %0, %3 offset:132\n\tds_write_b32 %0, %4 offset:196\n\t"
                     "ds_write_b32 %0, %5 offset:260\n\tds_write_b32 %0, %6 offset:324\n\tds_write_b32 %0, %7 offset:388\n\tds_write_b32 %0, %8 offset:452"
                     :: "v"(csm4), "v"(w[0]), "v"(w[1]), "v"(w[2]), "v"(w[3]), "v"(w[4]), "v"(w[5]), "v"(w[6]), "v"(w[7]));
        asm volatile("ds_read_b32 %0, %16\n\tds_read_b32 %1, %16 offset:64\n\tds_read_b32 %2, %16 offset:128\n\tds_read_b32 %3, %16 offset:192\n\t"
                     "ds_read_b32 %4, %16 offset:256\n\tds_read_b32 %5, %16 offset:320\n\tds_read_b32 %6, %16 offset:384\n\tds_read_b32 %7, %16 offset:448\n\t"
                     "ds_read_b32 %8, %16 offset:8\n\tds_read_b32 %9, %16 offset:72\n\tds_read_b32 %10, %16 offset:136\n\tds_read_b32 %11, %16 offset:200\n\t"
                     "ds_read_b32 %12, %16 offset:264\n\tds_read_b32 %13, %16 offset:328\n\tds_read_b32 %14, %16 offset:392\n\tds_read_b32 %15, %16 offset:456\n\t"
                     "s_waitcnt lgkmcnt(0)"
                     : "=&v"(pv[0]), "=&v"(pv[1]), "=&v"(pv[2]), "=&v"(pv[3]), "=&v"(pv[4]), "=&v"(pv[5]), "=&v"(pv[6]), "=&v"(pv[7]),
                       "=&v"(nx[0]), "=&v"(nx[1]), "=&v"(nx[2]), "=&v"(nx[3]), "=&v"(nx[4]), "=&v"(nx[5]), "=&v"(nx[6]), "=&v"(nx[7])
                     : "v"(csm4));
    }
    __device__ __forceinline__ void operator()(const f32x4 (&acc)[2][2][4][2], const Unit& u, int wr, int wc, int fr, int fq) const {
        const int b = u.pm / 17, it = u.pm % 17, s0 = 252 * it + 126 * wr - 1;
        const int colb = u.pn * 128 + wc * 32 + 8 * fq;
        const int lane = fq * 16 + fr;
        PG8_LAS float* wb = wbuf + (wr * 4 + wc) * 256;
        const unsigned cs = (unsigned)(size_t)(cbuf + (wr * 4 + wc) * 512 + fq * 128 + fr) - 4u;
        { const int gu = lane >> 5, c = lane & 31; const float* src = cw + gu * 2816 + u.pn * 128 + wc * 32 + c;
            const f32x4 t = {src[0], src[5632], src[2 * 5632], cb[gu * 2816 + u.pn * 128 + wc * 32 + c]}; *(PG8_LAS f32x4*)(wb + 4 * lane) = t; }
        float rs[8];
#pragma unroll
        for (int g = 0; g < 8; ++g) { const int s = s0 + 16 * g + fr; const bool ok = (s >= 0) && (s < 4096); const int row = b * 4096 + (ok ? s : 0);
            const float r = rscale_row(rss, row, fq, lane); rs[g] = ok ? r : 0.f; }
#define PIN8(x) asm volatile("" : "+v"(x[0]), "+v"(x[1]), "+v"(x[2]), "+v"(x[3]), "+v"(x[4]), "+v"(x[5]), "+v"(x[6]), "+v"(x[7]))
        unsigned pk[8][2][2][2];
#pragma unroll
        for (int g = 0; g < 8; ++g)
#pragma unroll
            for (int bj = 0; bj < 2; ++bj)
#pragma unroll
                for (int n = 0; n < 2; ++n) { const f32x4 x = acc[g >> 2][bj][g & 3][n] * rs[g]; pk[g][bj][n][0] = cvtpk(x[0], x[1]); pk[g][bj][n][1] = cvtpk(x[2], x[3]); }
#pragma unroll
        for (int n = 0; n < 2; ++n) {
            unsigned res[8][2];
#pragma unroll
            for (int qp = 0; qp < 2; ++qp) {
                float gate[2][8];
                { unsigned w[8], pv[8], nx[8];
#pragma unroll
                    for (int g = 0; g < 8; ++g) w[g] = pk[g][0][n][qp];
                    xch8(w, cs, pv, nx);
#pragma unroll
                    for (int qq = 0; qq < 2; ++qq) { const f32x4 t = *(const PG8_LAS f32x4*)(wb + 4 * (8 * fq + 4 * n + 2 * qp + qq));
                        f32x2_t o[4], e[4];
#pragma unroll
                        for (int gp = 0; gp < 4; ++gp) { const f32x2_t a = {unpk2(w[2 * gp], qq), unpk2(w[2 * gp + 1], qq)}, pp = {unpk2(pv[2 * gp], qq), unpk2(pv[2 * gp + 1], qq)}, xx = {unpk2(nx[2 * gp], qq), unpk2(nx[2 * gp + 1], qq)};
                            o[gp] = ((f32x2_t){t[3], t[3]} + (f32x2_t){t[1], t[1]} * a) + (f32x2_t){t[0], t[0]} * pp + (f32x2_t){t[2], t[2]} * xx; }
#pragma unroll
                        for (int gp = 0; gp < 4; ++gp) { const f32x2_t z = o[gp] * -1.4426950408889634f; e[gp].x = __builtin_amdgcn_exp2f(z.x); e[gp].y = __builtin_amdgcn_exp2f(z.y); }
#pragma unroll
                        for (int gp = 0; gp < 4; ++gp) { const f32x2_t d = e[gp] + 1.0f; f32x2_t r; r.x = __builtin_amdgcn_rcpf(d.x); r.y = __builtin_amdgcn_rcpf(d.y); const f32x2_t gg = o[gp] * r; gate[qq][2 * gp] = gg.x; gate[qq][2 * gp + 1] = gg.y; }
                        PIN8(gate[qq]); } }
                { unsigned w[8], pv[8], nx[8];
#pragma unroll
                    for (int g = 0; g < 8; ++g) w[g] = pk[g][1][n][qp];
                    xch8(w, cs, pv, nx);
#pragma unroll
                    for (int qq = 0; qq < 2; ++qq) { const f32x4 t = *(const PG8_LAS f32x4*)(wb + 4 * (32 + 8 * fq + 4 * n + 2 * qp + qq));
#pragma unroll
                        for (int gp = 0; gp < 4; ++gp) { const f32x2_t a = {unpk2(w[2 * gp], qq), unpk2(w[2 * gp + 1], qq)}, pp = {unpk2(pv[2 * gp], qq), unpk2(pv[2 * gp + 1], qq)}, xx = {unpk2(nx[2 * gp], qq), unpk2(nx[2 * gp + 1], qq)};
                            const f32x2_t o = ((f32x2_t){t[3], t[3]} + (f32x2_t){t[1], t[1]} * a) + (f32x2_t){t[0], t[0]} * pp + (f32x2_t){t[2], t[2]} * xx;
                            const f32x2_t gg = (f32x2_t){gate[qq][2 * gp], gate[qq][2 * gp + 1]} * o; gate[qq][2 * gp] = gg.x; gate[qq][2 * gp + 1] = gg.y; }
                        PIN8(gate[qq]); } }
#pragma unroll
                for (int g = 0; g < 8; ++g) res[g][qp] = cvtpk(gate[0][g], gate[1][g]);
            }
#pragma unroll
            for (int g = 0; g < 8; ++g) { const int j = 16 * g + fr, s = s0 + j;
                if (j >= 1 && j <= 126 && s < 4096) { u32x2 w = {res[g][0], res[g][1]}; *(u32x2*)(A2 + (size_t)(b * 4096 + s) * 2816 + colb + 4 * n) = w; } }
        }
#undef PIN8
        asm volatile("s_waitcnt lgkmcnt(0)" ::: "memory");
    }
};
template <class Epi, class Sched, bool ALIGN_EPI = false, bool SP2 = false, int AMODE = 0>
__device__ __forceinline__ void gemm_phase(PG8_LAS unsigned char* lds, const Gemm g, const Sched& S, const Epi& E, int wave0) {
    unsigned mk_ = ~0u; asm volatile("" : "+s"(mk_)); int tid_raw = (int)__builtin_amdgcn_mbcnt_hi(mk_, __builtin_amdgcn_mbcnt_lo(mk_, 0u)); asm volatile("" : "+v"(tid_raw)); tid_raw += wave0 * 64; const int tid = tid_raw, wid = __builtin_amdgcn_readfirstlane(tid >> 6), lane = tid & 63, wr = wid >> 2, wc = wid & 3, fr = lane & 15, fq = lane >> 4;
    const int K = g.K, nt = K / BK;
    unsigned voffA[2], voffB[2];
#pragma unroll
    for (int i = 0; i < 2; ++i) { int R, C; stage_rc(tid * 16 + i * 8192, R, C); const int Rb = Epi::PERM ? ((R & ~31) + perm32(R & 31)) : R;
        const int Ra = AMODE ? ((R & 63) + 126 * (R >> 6)) : R; voffA[i] = (unsigned)(Ra * K + C) * 2u; voffB[i] = (unsigned)(Rb * K + C) * 2u; }
    const size_t kstep = (size_t)(BK * 2);
    const size_t hstep = (size_t)HALF * K * 2;
    const size_t tstep = 2 * hstep;
    const size_t hstepA = AMODE ? (size_t)64 * K * 2 : hstep;
#define PG8_ABASE(pm_) (AMODE ? (const char*)g.A + ((long)(((pm_) / 17) * 4096 + 252 * ((pm_) % 17) - 1)) * (long)K * 2 : (const char*)g.A + (size_t)(pm_) * tstep)
    const unsigned ldsw = (unsigned)wid * 1024u;
    const int aoff = lds_byte(wr * 64 + fr, fq * 8), boff = lds_byte(wc * 32 + fr, fq * 8);
#define PG8_SA(b, h) (((b) * 2 + (h)) * HTB)
#define PG8_SB(b, h) ((4 + (b) * 2 + (h)) * HTB)
#define PG8_STAGE(bufoff, gbase, voff) do { _Pragma("unroll") for (int _i = 0; _i < 2; ++_i) \
        __builtin_amdgcn_global_load_lds((const unsigned*)((const char*)(gbase) + (voff)[_i]), (PG8_LAS unsigned*)(lds + (bufoff) + ldsw + _i * 8192), 16, 0, 0); } while (0)
#define PG8_LDA(dst, b, h) do { _Pragma("unroll") for (int m = 0; m < 4; ++m) _Pragma("unroll") for (int k = 0; k < 2; ++k) dst[m][k] = *(const PG8_LAS bf16x8*)(lds + PG8_SA(b, h) + aoff + m * 2048 + k * 1024); } while (0)
#define PG8_LDB(dst, b, h) do { _Pragma("unroll") for (int n = 0; n < 2; ++n) _Pragma("unroll") for (int k = 0; k < 2; ++k) dst[n][k] = *(const PG8_LAS bf16x8*)(lds + PG8_SB(b, h) + boff + n * 2048 + k * 1024); } while (0)
#define PG8_MMA(ai, bj, At, Bt) do { __builtin_amdgcn_s_setprio(1); _Pragma("unroll") for (int m = 0; m < 4; ++m) _Pragma("unroll") for (int n = 0; n < 2; ++n) _Pragma("unroll") for (int k = 0; k < 2; ++k) \
        acc[ai][bj][m][n] = __builtin_amdgcn_mfma_f32_16x16x32_bf16(Bt[n][k], At[m][k], acc[ai][bj][m][n], 0, 0, 0); __builtin_amdgcn_s_setprio(0); } while (0)
#define PG8_WAIT_V(n) asm volatile("s_waitcnt vmcnt(" #n ")" ::: "memory")
#define PG8_WAIT_L(n) asm volatile("s_waitcnt lgkmcnt(" #n ")" ::: "memory")
#define PG8_BAR __builtin_amdgcn_s_barrier()
#define PG8_SCHED __builtin_amdgcn_sched_barrier(0)
    Unit cur, nxt; int ui = 0;
    if (!S.next(0, cur)) return;
    f32x4 acc[2][2][4][2];
#pragma unroll
    for (int a = 0; a < 2; ++a)
#pragma unroll
        for (int b = 0; b < 2; ++b)
#pragma unroll
            for (int m = 0; m < 4; ++m)
#pragma unroll
                for (int n = 0; n < 2; ++n) acc[a][b][m][n] = (f32x4){0.f, 0.f, 0.f, 0.f};
    bf16x8 At[4][2], B0[2][2], B1[2][2];
    const char* cA = PG8_ABASE(cur.pm); const char* cB = (const char*)g.Bt + (size_t)cur.pn * tstep;
    S.a_ready(cur);
    if constexpr (SP2) {
        PG8_STAGE(PG8_SB(0, 0), cB, voffB); PG8_STAGE(PG8_SB(0, 1), cB + hstep, voffB); PG8_STAGE(PG8_SA(0, 0), cA, voffA); PG8_STAGE(PG8_SA(0, 1), cA + hstepA, voffA);
        if (wr == 1) PG8_BAR;
        PG8_WAIT_V(2); PG8_BAR;
        PG8_STAGE(PG8_SB(1, 0), cB + kstep, voffB); PG8_STAGE(PG8_SA(1, 0), cA + kstep, voffA); PG8_STAGE(PG8_SB(1, 1), cB + hstep + kstep, voffB);
        PG8_WAIT_V(6); PG8_BAR;
    } else {
        PG8_STAGE(PG8_SB(0, 0), cB, voffB); PG8_STAGE(PG8_SA(0, 0), cA, voffA); PG8_STAGE(PG8_SB(0, 1), cB + hstep, voffB); PG8_STAGE(PG8_SA(0, 1), cA + hstepA, voffA);
        if (wr == 1) PG8_BAR;
        PG8_WAIT_V(4); PG8_BAR;
        PG8_STAGE(PG8_SB(1, 0), cB + kstep, voffB); PG8_STAGE(PG8_SA(1, 0), cA + kstep, voffA); PG8_STAGE(PG8_SB(1, 1), cB + hstep + kstep, voffB);
        PG8_WAIT_V(6); PG8_BAR;
    }
    for (;;) {
        const bool has_next = S.next(ui + 1, nxt);
        const char* nA = has_next ? PG8_ABASE(nxt.pm) : cA; const char* nB = has_next ? (const char*)g.Bt + (size_t)nxt.pn * tstep : cB;
        for (int t = 0; t < nt; t += 2) {
            const bool last = (t == nt - 2);
            const char* a1 = cA + (size_t)(t + 1) * kstep;
            const char* a2 = last ? nA : cA + (size_t)(t + 2) * kstep; const char* b2 = last ? nB : cB + (size_t)(t + 2) * kstep;
            const char* a3 = a2 + kstep; const char* b3 = b2 + kstep;
            if (last && has_next) S.a_ready(nxt);
            if constexpr (SP2) {
            PG8_LDB(B0, 0, 0); PG8_LDB(B1, 0, 1); PG8_SCHED; PG8_LDA(At, 0, 0); PG8_STAGE(PG8_SA(1, 1), a1 + hstepA, voffA);
            PG8_WAIT_V(8); PG8_WAIT_L(0); PG8_BAR; PG8_MMA(0, 0, At, B0); PG8_MMA(0, 1, At, B1); PG8_BAR; PG8_SCHED;
            PG8_LDA(At, 0, 1); PG8_STAGE(PG8_SB(0, 0), b2, voffB); PG8_STAGE(PG8_SB(0, 1), b2 + hstep, voffB); PG8_STAGE(PG8_SA(0, 0), a2, voffA);
            PG8_WAIT_V(8); PG8_WAIT_L(0); PG8_BAR; PG8_MMA(1, 0, At, B0); PG8_MMA(1, 1, At, B1); PG8_BAR; PG8_SCHED;
            PG8_LDB(B0, 1, 0); PG8_LDB(B1, 1, 1); PG8_SCHED; PG8_LDA(At, 1, 0); PG8_STAGE(PG8_SA(0, 1), a2 + hstepA, voffA);
            PG8_WAIT_V(8); PG8_WAIT_L(0); PG8_BAR; PG8_MMA(0, 0, At, B0); PG8_MMA(0, 1, At, B1); PG8_BAR; PG8_SCHED;
            PG8_LDA(At, 1, 1); PG8_STAGE(PG8_SB(1, 0), b3, voffB); PG8_STAGE(PG8_SB(1, 1), b3 + hstep, voffB); PG8_STAGE(PG8_SA(1, 0), a3, voffA);
            PG8_WAIT_V(8); PG8_WAIT_L(0); PG8_BAR; PG8_MMA(1, 0, At, B0); PG8_MMA(1, 1, At, B1); PG8_BAR; PG8_SCHED;
            } else {
            PG8_LDB(B0, 0, 0); PG8_SCHED; PG8_LDA(At, 0, 0); PG8_STAGE(PG8_SA(1, 1), a1 + hstepA, voffA);
            PG8_WAIT_L(8); PG8_BAR; PG8_WAIT_L(0); PG8_MMA(0, 0, At, B0); PG8_BAR; PG8_SCHED;
            PG8_LDB(B1, 0, 1); PG8_STAGE(PG8_SB(0, 0), b2, voffB);
            PG8_BAR; PG8_WAIT_L(0); PG8_MMA(0, 1, At, B1); PG8_BAR;
            PG8_LDA(At, 0, 1); PG8_STAGE(PG8_SA(0, 0), a2, voffA);
            PG8_BAR; PG8_WAIT_L(0); PG8_MMA(1, 0, At, B0); PG8_BAR; PG8_SCHED;
            PG8_STAGE(PG8_SB(0, 1), b2 + hstep, voffB);
            PG8_WAIT_V(6); PG8_BAR; PG8_MMA(1, 1, At, B1); PG8_BAR;
            PG8_LDB(B0, 1, 0); PG8_SCHED; PG8_LDA(At, 1, 0); PG8_STAGE(PG8_SA(0, 1), a2 + hstepA, voffA);
            PG8_WAIT_L(8); PG8_BAR; PG8_WAIT_L(0); PG8_MMA(0, 0, At, B0); PG8_BAR; PG8_SCHED;
            PG8_LDB(B1, 1, 1); PG8_STAGE(PG8_SB(1, 0), b3, voffB);
            PG8_BAR; PG8_WAIT_L(0); PG8_MMA(0, 1, At, B1); PG8_BAR;
            PG8_LDA(At, 1, 1); PG8_STAGE(PG8_SA(1, 0), a3, voffA);
            PG8_BAR; PG8_WAIT_L(0); PG8_MMA(1, 0, At, B0); PG8_BAR; PG8_SCHED;
            PG8_STAGE(PG8_SB(1, 1), b3 + hstep, voffB);
            PG8_WAIT_V(6); PG8_BAR; PG8_MMA(1, 1, At, B1); PG8_BAR;
            }
        }
        if constexpr (ALIGN_EPI) { if (wr == 0) PG8_BAR; }
        if constexpr (!Epi::AFTER_DRAIN) { E(acc, cur, wr, wc, fr, fq); S.done(cur); }
        if (!has_next) break;
#pragma unroll
        for (int a = 0; a < 2; ++a)
#pragma unroll
            for (int b = 0; b < 2; ++b)
#pragma unroll
                for (int m = 0; m < 4; ++m)
#pragma unroll
                    for (int n = 0; n < 2; ++n) acc[a][b][m][n] = (f32x4){0.f, 0.f, 0.f, 0.f};
        cur = nxt; cA = nA; cB = nB; ++ui;
        if constexpr (ALIGN_EPI) { if (wr == 1) PG8_BAR; }
    }
    PG8_WAIT_V(0);
    if constexpr (!ALIGN_EPI) { if (wr == 0) PG8_BAR; }
    PG8_BAR;
    if constexpr (Epi::AFTER_DRAIN) { E.fused(acc, cur, wr, wc, fr, fq, lds, wid, lane); S.done(cur); }
#undef PG8_SA
#undef PG8_ABASE
#undef PG8_SB
#undef PG8_STAGE
#undef PG8_LDA
#undef PG8_LDB
#undef PG8_MMA
#undef PG8_WAIT_V
#undef PG8_WAIT_L
#undef PG8_BAR
#undef PG8_SCHED
}
}
namespace attn {
using bf16x8 = __attribute__((ext_vector_type(8))) short;
using s16x4  = __attribute__((ext_vector_type(4))) short;
using f32x16 = __attribute__((ext_vector_type(16))) float;
using f32x4  = __attribute__((ext_vector_type(4))) float;
using u32x4  = __attribute__((ext_vector_type(4))) unsigned;
typedef unsigned short bf16_t;
constexpr int NW = 8, QBLK = 32, KVBLK = 64, LDQ = 512, LDK = 512, SEQ = 4096, LDY = 1024;
#define SBAR() __builtin_amdgcn_sched_barrier(0)
__device__ __forceinline__ int crow(int r, int hi) { return (r & 3) + 8 * (r >> 2) + 4 * hi; }
typedef float f32x2_t __attribute__((ext_vector_type(2))); typedef __bf16 bf16x2_t __attribute__((ext_vector_type(2)));
__device__ __forceinline__ unsigned cvtpk(float lo, float hi) { f32x2_t v = {lo, hi}; bf16x2_t b = __builtin_convertvector(v, bf16x2_t); return __builtin_bit_cast(unsigned, b); }

__device__ __forceinline__ int v_rd_base(int lane) { return ((lane & 3) << 3) | (((lane >> 2) & 3) << 6) | (((lane >> 4) & 1) << 5) | (((lane >> 5) & 1) << 8); }
constexpr int v_rd_off(int d0, int ks, int half) { return d0 * 512 + ks * 4096 + half * 2048; }
template <int OFF> __device__ __forceinline__ s16x4 tr_read(int vb) {
  s16x4 r; asm volatile("ds_read_b64_tr_b16 %0, %1 offset:%2" : "=&v"(r) : "v"(vb), "i"(OFF) : "memory"); return r;
}
constexpr int A2_K = 0, A2_V = 32768, A2_Q = 81920, A2_WS = 147456, A2_OB = 0;
typedef __attribute__((address_space(3))) char lchar;
typedef __attribute__((address_space(3))) unsigned luint;
#define GLDS16(gp, lp) __builtin_amdgcn_global_load_lds((const unsigned*)(gp), (luint*)(lp), 16, 0, 0)
__device__ __forceinline__ void glds16_so(const void* sbase, unsigned voff, unsigned lds_dst) {
  unsigned keep; asm volatile("s_nop 4\n\ts_mov_b32 %0, m0\n\ts_mov_b32 m0, %3\n\ts_nop 0\n\tglobal_load_lds_dwordx4 %1, %2\n\ts_mov_b32 m0, %0" : "=&s"(keep) : "v"(voff), "s"(sbase), "s"(lds_dst) : "memory"); }
template <int D0> __device__ __forceinline__ void pv2_one(f32x16& oa, f32x16& ob, int vb, const bf16x8 (&pa)[4], const bf16x8 (&pb)[4]) {
#define PK(L, H) (bf16x8){L[0], L[1], L[2], L[3], H[0], H[1], H[2], H[3]}
  { const s16x4 l0 = tr_read<v_rd_off(D0, 0, 0)>(vb), h0 = tr_read<v_rd_off(D0, 0, 1)>(vb), l1 = tr_read<v_rd_off(D0, 1, 0)>(vb), h1 = tr_read<v_rd_off(D0, 1, 1)>(vb);
    asm volatile("s_waitcnt lgkmcnt(0)" ::: "memory"); SBAR();
    const bf16x8 v0 = PK(l0, h0), v1 = PK(l1, h1);
    __builtin_amdgcn_s_setprio(1);
    oa = __builtin_amdgcn_mfma_f32_32x32x16_bf16(pa[0], v0, oa, 0, 0, 0); ob = __builtin_amdgcn_mfma_f32_32x32x16_bf16(pb[0], v0, ob, 0, 0, 0);
    oa = __builtin_amdgcn_mfma_f32_32x32x16_bf16(pa[1], v1, oa, 0, 0, 0); ob = __builtin_amdgcn_mfma_f32_32x32x16_bf16(pb[1], v1, ob, 0, 0, 0); __builtin_amdgcn_s_setprio(0); }
  { const s16x4 l2 = tr_read<v_rd_off(D0, 2, 0)>(vb), h2 = tr_read<v_rd_off(D0, 2, 1)>(vb), l3 = tr_read<v_rd_off(D0, 3, 0)>(vb), h3 = tr_read<v_rd_off(D0, 3, 1)>(vb);
    asm volatile("s_waitcnt lgkmcnt(0)" ::: "memory"); SBAR();
    const bf16x8 v2 = PK(l2, h2), v3 = PK(l3, h3);
    __builtin_amdgcn_s_setprio(1);
    oa = __builtin_amdgcn_mfma_f32_32x32x16_bf16(pa[2], v2, oa, 0, 0, 0); ob = __builtin_amdgcn_mfma_f32_32x32x16_bf16(pb[2], v2, ob, 0, 0, 0);
    oa = __builtin_amdgcn_mfma_f32_32x32x16_bf16(pa[3], v3, oa, 0, 0, 0); ob = __builtin_amdgcn_mfma_f32_32x32x16_bf16(pb[3], v3, ob, 0, 0, 0); __builtin_amdgcn_s_setprio(0); }
#undef PK
}
__device__ __forceinline__ void pv2(f32x16 (&oa)[4], f32x16 (&ob)[4], int vb, const bf16x8 (&pa)[4], const bf16x8 (&pb)[4]) {
  pv2_one<0>(oa[0], ob[0], vb, pa, pb); pv2_one<1>(oa[1], ob[1], vb, pa, pb); pv2_one<2>(oa[2], ob[2], vb, pa, pb); pv2_one<3>(oa[3], ob[3], vb, pa, pb);
}
template <int D0A, int D0B> __device__ __forceinline__ void qk_load(const lchar* Ks, int koff, int comp, bf16x8 (&k0)[4], bf16x8 (&k1)[4]) {
  typedef __attribute__((address_space(3))) bf16x8 lfrag;
#pragma unroll
  for (int d0 = D0A; d0 < D0B; ++d0) { const int off = (koff & ~0xF0) | ((koff ^ ((comp * 8 + d0 * 2) << 4)) & 0xF0);
    k0[d0] = *(const lfrag*)(Ks + off); k1[d0] = *(const lfrag*)(Ks + off + 8192); }
}
__device__ __forceinline__ void qk_mma(const bf16x8 (&q)[4], const bf16x8 (&k0)[4], const bf16x8 (&k1)[4], f32x16& p0, f32x16& p1) {
  p0 = __builtin_amdgcn_mfma_f32_32x32x16_bf16(k0[0], q[0], f32x16{}, 0, 0, 0); p1 = __builtin_amdgcn_mfma_f32_32x32x16_bf16(k1[0], q[0], f32x16{}, 0, 0, 0);
#pragma unroll
  for (int d0 = 1; d0 < 4; ++d0) { p0 = __builtin_amdgcn_mfma_f32_32x32x16_bf16(k0[d0], q[d0], p0, 0, 0, 0); p1 = __builtin_amdgcn_mfma_f32_32x32x16_bf16(k1[d0], q[d0], p1, 0, 0, 0); }
}
__device__ __forceinline__ void sm_part(f32x16& p0, f32x16& p1, float mref, bool use_ref, float& l_reg, bf16x8 (&pa)[4]) {
#define PK4(P, BASE, OUT) do { u32x4 w = {cvtpk(P[BASE + 0], P[BASE + 1]), cvtpk(P[BASE + 2], P[BASE + 3]), cvtpk(P[BASE + 4], P[BASE + 5]), cvtpk(P[BASE + 6], P[BASE + 7])}; \
    OUT = *reinterpret_cast<bf16x8*>(&w); } while (0)
  if (use_ref) {
    float m_ = mref; asm volatile("" : "+v"(m_));
#pragma unroll
    for (int r = 0; r < 16; ++r) { p0[r] -= m_; p1[r] -= m_; } }
  { float ps[4] = {0.f, 0.f, 0.f, 0.f};
#pragma unroll
    for (int r = 0; r < 16; ++r) { p0[r] = __builtin_amdgcn_exp2f(p0[r]); ps[r & 3] += p0[r]; }
    l_reg += (ps[0] + ps[1]) + (ps[2] + ps[3]); asm volatile("" : "+v"(l_reg));
    PK4(p0, 0, pa[0]); PK4(p0, 8, pa[1]); }
  { float ps[4] = {0.f, 0.f, 0.f, 0.f};
#pragma unroll
    for (int r = 0; r < 16; ++r) { p1[r] = __builtin_amdgcn_exp2f(p1[r]); ps[r & 3] += p1[r]; }
    l_reg += (ps[0] + ps[1]) + (ps[2] + ps[3]); asm volatile("" : "+v"(l_reg));
    PK4(p1, 0, pa[2]); PK4(p1, 8, pa[3]); }
#undef PK4
  asm volatile("" : "+v"(pa[0]), "+v"(pa[1]), "+v"(pa[2]), "+v"(pa[3]));
}
__device__ __forceinline__ void attn_unit2(const bf16_t* __restrict__ Qg, const bf16_t* __restrict__ Kg, const bf16_t* __restrict__ Vg, bf16_t* __restrict__ Yg,
                                           int b, int h, int q0, float lam, float lam_init, const float* __restrict__ subg, const unsigned* __restrict__ kmax2, lchar* lds, int wave0) {
  unsigned mk_ = ~0u; asm volatile("" : "+s"(mk_)); int tid_raw = (int)__builtin_amdgcn_mbcnt_hi(mk_, __builtin_amdgcn_mbcnt_lo(mk_, 0u)); asm volatile("" : "+v"(tid_raw)); tid_raw += wave0 * 64; const int tid = tid_raw, wid = __builtin_amdgcn_readfirstlane(tid >> 6), lane = tid & 63, r32 = lane & 31, hi = lane >> 5;
  const bool grpB = wid >= 4;
  const long rowbase = (long)b * SEQ;
  const bf16_t* Kh = Kg + rowbase * LDK + h * 128; const bf16_t* Vh = Vg + rowbase * LDK + h * 128;
  unsigned koffs[2], voffs[2];
#pragma unroll
  for (int ii = 0; ii < 2; ++ii) { const int s = 64 * (2 * wid + ii) + lane; const int row = s >> 4, ch = (s & 15) ^ (row & 15); koffs[ii] = (unsigned)(row * LDK + ch * 8) * 2u;
    const int st = s >> 5, kk = (st >> 2) * 8 + ((s >> 2) & 7), k = kk  , c8 = (st & 3) * 4 + (s & 3); voffs[ii] = (unsigned)(k * LDK + c8 * 8) * 2u; }
  lchar* Qw = lds + A2_Q + wid * 8192; const unsigned ldsb = (unsigned)(size_t)lds;
  { const bf16_t* Qrow = Qg + (rowbase + q0 + wid * QBLK) * LDQ + h * 128;
#pragma unroll
    for (int i = 0; i < 8; ++i) { const int s = 64 * i + lane, row = s >> 4, ch = (s & 15) ^ (row & 15); GLDS16(Qrow + row * LDQ + ch * 8, Qw + i * 1024); } }
#define DMA_KV(t, sk, sv) do { const char* kt_ = (const char*)(Kh + (long)(t) * KVBLK * LDK); const char* vt_ = (const char*)(Vh + (long)(t) * KVBLK * LDK); \
    _Pragma("unroll") for (int ii = 0; ii < 2; ++ii) { glds16_so(kt_, koffs[ii], ldsb + A2_K + (sk) * 16384 + (2 * wid + ii) * 1024); \
    glds16_so(vt_, voffs[ii], ldsb + A2_V + (sv) * 16384 + (2 * wid + ii) * 1024); } } while (0)
  DMA_KV(0, 0, 0);
  const int koff = r32 * 256 + (((hi) ^ (r32 & 15)) << 4);
  const int vb0 = (int)(size_t)(lds + A2_V) + v_rd_base(lane);
  float l1 = 0.f, l2 = 0.f, mref1, mref2; f32x16 o1[4] = {}, o2[4] = {}; bf16x8 pa1[4], pa2[4];
  asm volatile("s_waitcnt vmcnt(0)" ::: "memory");
  bf16x8 qf1[4], qf2[4];
  { float qa = 0.f, qb = 0.f;
#pragma unroll
    for (int d0 = 0; d0 < 4; ++d0) { const int off = (koff & ~0xF0) | ((koff ^ ((d0 * 2) << 4)) & 0xF0);
      const bf16x8 x = *(const __attribute__((address_space(3))) bf16x8*)(Qw + off), y = *(const __attribute__((address_space(3))) bf16x8*)(Qw + (off ^ 0x80)); qf1[d0] = x; qf2[d0] = y;
#pragma unroll
      for (int j = 0; j < 8; ++j) { const float fx = __uint_as_float((unsigned)(unsigned short)x[j] << 16), fy = __uint_as_float((unsigned)(unsigned short)y[j] << 16); qa += fx * fx; qb += fy * fy; } }
    qa = lx_sum32(qa);
    qb = lx_sum32(qb);
    const float ka = __uint_as_float(kmax2[(b * 4 + h) * 2 + 0]), kb = __uint_as_float(kmax2[(b * 4 + h) * 2 + 1]);
    mref1 = fmaxf(__builtin_amdgcn_sqrtf(qa * ka) * 1.001f - 64.f, 0.f); mref2 = fmaxf(__builtin_amdgcn_sqrtf(qb * kb) * 1.001f - 64.f, 0.f); }
  const bool use_ref = __any((mref1 != 0.f) || (mref2 != 0.f));
  const int NT = SEQ / KVBLK; int sk = 0, sv = 0, svp = 0;
  for (int j = 0; j < NT; ++j) {
    asm volatile("s_waitcnt vmcnt(0) lgkmcnt(0)\n\ts_barrier" ::: "memory");
    const int skn = sk ^ 1, svn = (sv == 2) ? 0 : sv + 1;
    if (j + 1 < NT) DMA_KV(j + 1, skn, svn);
    { bf16x8 kA0[4], kA1[4], kB0[4], kB1[4]; f32x16 sa0, sa1, sb0, sb1;
      qk_load<0, 4>(lds + A2_K + sk * 16384, koff, 0, kA0, kA1); SBAR();
      if (grpB && j > 0) pv2(o1, o2, vb0 + svp * 16384, pa1, pa2);
      qk_mma(qf1, kA0, kA1, sa0, sa1);
      qk_load<0, 2>(lds + A2_K + sk * 16384, koff, 1, kB0, kB1); SBAR();
      sm_part(sa0, sa1, mref1, use_ref, l1, pa1);
      SBAR();
      qk_load<2, 4>(lds + A2_K + sk * 16384, koff, 1, kB0, kB1);
      qk_mma(qf2, kB0, kB1, sb0, sb1);
      __builtin_amdgcn_sched_group_barrier(0x8, 2, 0); __builtin_amdgcn_sched_group_barrier(0x100, 2, 0); __builtin_amdgcn_sched_group_barrier(0x8, 2, 0); __builtin_amdgcn_sched_group_barrier(0x100, 2, 0);
      __builtin_amdgcn_sched_group_barrier(0x8, 4, 0); SBAR();
      sm_part(sb0, sb1, mref2, use_ref, l2, pa2); }
    if (!grpB) pv2(o1, o2, vb0 + sv * 16384, pa1, pa2);
    svp = sv; sk = skn; sv = svn;
  }
  if (grpB) pv2(o1, o2, vb0 + svp * 16384, pa1, pa2);
#undef DMA_KV
  unsigned mk2_ = ~0u; asm volatile("" : "+s"(mk2_)); int lane_e = (int)__builtin_amdgcn_mbcnt_hi(mk2_, __builtin_amdgcn_mbcnt_lo(mk2_, 0u)); asm volatile("" : "+v"(lane_e));
  l1 = lx_sum32(l1);
  l2 = lx_sum32(l2);
  __attribute__((address_space(3))) float* wsf = (__attribute__((address_space(3))) float*)(lds + A2_WS) + wid * 64;
  const int r32e = lane_e & 31, hie = lane_e >> 5;
  const float* subg_e = subg; asm volatile("" : "+s"(subg_e));
  if (hie == 0) { wsf[r32e] = __builtin_amdgcn_rcpf(l1); wsf[32 + r32e] = lam * __builtin_amdgcn_rcpf(l2); }
  asm volatile("s_waitcnt vmcnt(0) lgkmcnt(0)\n\ts_barrier" ::: "memory");
  __attribute__((address_space(3))) float* OB = (__attribute__((address_space(3))) float*)(lds + A2_OB + wid * 16384);
#pragma unroll
  for (int r = 0; r < 16; ++r) { const int orow = crow(r, hie); const float ra = wsf[orow], rb = wsf[32 + orow];
#pragma unroll
    for (int d0 = 0; d0 < 4; ++d0) { const int col = d0 * 32 + r32e; OB[orow * 128 + ((((col >> 2) ^ (orow & 7)) << 2) | (col & 3))] = o1[d0][r] * ra - o2[d0][r] * rb; } }
  asm volatile("s_waitcnt lgkmcnt(0)" ::: "memory");
  { const int row = lane_e >> 1, half = lane_e & 1; float ss = 0.f;
#pragma unroll
    for (int i = 0; i < 16; ++i) { const f32x4 v = *(const __attribute__((address_space(3))) f32x4*)(OB + row * 128 + (((16 * half + i) ^ (row & 7)) << 2)); ss += (v[0] * v[0] + v[1] * v[1]) + (v[2] * v[2] + v[3] * v[3]); }
    ss += __builtin_bit_cast(float, __builtin_amdgcn_update_dpp(0, __builtin_bit_cast(int, ss), 0xB1, 0xf, 0xf, false));
    float li_ = lam_init; asm volatile("" : "+s"(li_));
    const float rstd = (1.0f - li_) * __builtin_amdgcn_rsqf(ss * (1.0f / 128.0f) + 1e-5f);
    bf16_t* yp = Yg + (rowbase + q0 + wid * QBLK + row) * LDY + h * 128 + half * 64;
#pragma unroll 2
    for (int i = 0; i < 8; ++i) { const f32x4 g0 = *(const f32x4*)(subg_e + half * 64 + 8 * i), g1 = *(const f32x4*)(subg_e + half * 64 + 8 * i + 4);
      const f32x4 va = *(const __attribute__((address_space(3))) f32x4*)(OB + row * 128 + (((16 * half + 2 * i) ^ (row & 7)) << 2)), vc = *(const __attribute__((address_space(3))) f32x4*)(OB + row * 128 + (((16 * half + 2 * i + 1) ^ (row & 7)) << 2));
      const f32x4 a = va * g0 * rstd, c = vc * g1 * rstd;
      u32x4 w = {cvtpk(a[0], a[1]), cvtpk(a[2], a[3]), cvtpk(c[0], c[1]), cvtpk(c[2], c[3])};
      *(u32x4*)(yp + 8 * i) = w; } }
  asm volatile("s_waitcnt vmcnt(0) lgkmcnt(0)\n\ts_barrier" ::: "memory");
}
#undef GLDS16
#undef SBAR
}
#define LAS __attribute__((address_space(3)))
#define XB_TMO      128
#define XB_XCNT(j)  (256  + 64 * (j))
#define XB_XSUB(j)  (1280 + 64 * (j))
#define XB_XGEN(j)  (2304 + 64 * (j))
#define XB_TOP      3328
#define XB_TOPGEN   3392
#define XCD_BAR_WORDS 3456
#define XB_SPIN_CAP (1u << 18)

__device__ __forceinline__ unsigned xb_ld(unsigned* p)              { asm volatile("" : "+v"(p)); return __hip_atomic_load(p, __ATOMIC_RELAXED, __HIP_MEMORY_SCOPE_AGENT); }
__device__ __forceinline__ unsigned xb_add(unsigned* p, unsigned v) { asm volatile("" : "+v"(p), "+v"(v)); return __hip_atomic_fetch_add(p, v, __ATOMIC_RELAXED, __HIP_MEMORY_SCOPE_AGENT); }
__device__ __forceinline__ unsigned xb_xcc_id() { return (unsigned)__builtin_amdgcn_s_getreg((3 << 11) | 20) & 0xFu; }
#define XB_SPIN(cond, bar) do { unsigned _sp = 0; while (cond) { __builtin_amdgcn_s_sleep(1); \
    if ((++_sp & 255u) == 0u) { if (xb_ld(&(bar)[XB_TMO])) break; if (_sp > XB_SPIN_CAP) { atomicAdd(&(bar)[XB_TMO], 1u); break; } } } } while (0)

__device__ __forceinline__ bool xb_lane0() { unsigned mk_ = ~0u; asm volatile("" : "+s"(mk_)); return __builtin_amdgcn_mbcnt_hi(mk_, __builtin_amdgcn_mbcnt_lo(mk_, 0u)) == 0u; }
struct XcdBarrier {
    int w0;
    unsigned* bar; unsigned x;
    volatile LAS unsigned* st;
};

__device__ __forceinline__ XcdBarrier xcd_barrier_post(unsigned* bar, volatile LAS unsigned* st, int w0) {
    XcdBarrier b; b.w0 = w0; b.bar = bar; b.x = xb_xcc_id(); b.st = st;
    if (b.w0 == 0 && xb_lane0()) (void)xb_add(&bar[XB_XCNT(b.x)], 1u);
    return b;
}
__device__ __forceinline__ void xcd_barrier_complete(unsigned* bar, unsigned x, unsigned& nloc, unsigned& nx) {
    const unsigned G = gridDim.x * gridDim.y * gridDim.z;
    unsigned sum, cnt, mine, sp = 0u;
    for (;;) {
        sum = 0u; cnt = 0u; mine = 0u;
#pragma unroll
        for (unsigned j = 0; j < 16; ++j) { const unsigned c = xb_ld(&bar[XB_XCNT(j)]); sum += c; cnt += (c > 0u) ? 1u : 0u; mine = (j == x) ? c : mine; }
        if (sum == G) break;
        __builtin_amdgcn_s_sleep(1);
        if ((++sp & 255u) == 0u) { if (xb_ld(&bar[XB_TMO])) break; if (sp > XB_SPIN_CAP) { atomicAdd(&bar[XB_TMO], 1u); break; } }
    }
    nloc = mine > 0u ? mine : 1u; nx = cnt > 0u ? cnt : 1u;
}

__device__ __forceinline__ void xcd_barrier(const XcdBarrier& b) {
    asm volatile("s_waitcnt vmcnt(0)" ::: "memory");
    __syncthreads();
    if (b.w0 == 0 && xb_lane0()) {
        unsigned* bar = b.bar;
        __builtin_amdgcn_s_waitcnt(0);
        unsigned nloc = b.st[0], nx = b.st[1];
        if (nloc == 0u) { xcd_barrier_complete(bar, b.x, nloc, nx); b.st[0] = nloc; b.st[1] = nx; }
        const unsigned old = xb_add(&bar[XB_XSUB(b.x)], 1u);
        const unsigned gen = old / nloc;
        if (old + 1u == (gen + 1u) * nloc) {
            __builtin_amdgcn_fence(__ATOMIC_RELEASE, "agent");
            asm volatile("s_waitcnt vmcnt(0)" ::: "memory");
            const unsigned og = xb_add(&bar[XB_TOP], 1u);
            const unsigned tg = og / nx;
            if (og + 1u == (tg + 1u) * nx) xb_add(&bar[XB_TOPGEN], 1u);
            else XB_SPIN(xb_ld(&bar[XB_TOPGEN]) == tg, bar);
            __builtin_amdgcn_fence(__ATOMIC_ACQUIRE, "agent");
            xb_add(&bar[XB_XGEN(b.x)], 1u);
            asm volatile("s_waitcnt vmcnt(0)" ::: "memory");
        } else {
            XB_SPIN(xb_ld(&bar[XB_XGEN(b.x)]) == gen, bar);
            __builtin_amdgcn_fence(__ATOMIC_ACQUIRE, "agent");
            asm volatile("s_waitcnt vmcnt(0)" ::: "memory");
        }
    }
    __syncthreads();
}
#undef LAS
#define LAS __attribute__((address_space(3)))
typedef unsigned short bf16;
typedef float f32x4 __attribute__((ext_vector_type(4)));
typedef float f32x16 __attribute__((ext_vector_type(16)));
typedef short bf16x8 __attribute__((ext_vector_type(8)));
typedef short s16x4 __attribute__((ext_vector_type(4)));
typedef unsigned u32x4 __attribute__((ext_vector_type(4)));
typedef unsigned u32x2 __attribute__((ext_vector_type(2)));
typedef short v4i16_t __attribute__((ext_vector_type(4)));

constexpr int NWAVES = 8, NTHREADS = 512;
constexpr int BATCH = 4, SEQ = 4096, D = 1024, DEPTH = 4, M = BATCH * SEQ;
constexpr int IN_COLS = 3336, IN_MAIN = 3328, DFF = 2816, UPW = 5632;
constexpr float LOG2E = 1.4426950408889634f;
constexpr int LDS_BYTES = 163840, LDSCTL_OFF = LDS_BYTES - 512;

constexpr size_t MiB = 1u << 20;
constexpr size_t WS_CTL = 0, CTL_ZERO_BYTES = 64 * 1024;
constexpr size_t WS_COS = 1 * MiB, WS_SIN = WS_COS + 512 * 1024, WS_RSS = 2 * MiB, WS_DT = 3 * MiB, WS_CD = WS_DT + 512 * 1024, WS_KMAX = WS_CD + 65536, WS_SSDV = 4 * MiB;
constexpr size_t WS_W0 = 8 * MiB, W_LAYER = 25 * MiB, WO_IN = 0, WO_OUT = 6815744, WO_UP = WO_OUT + 2 * MiB, WO_DOWN = WO_UP + 11 * MiB;
constexpr size_t WS_XG = 108 * MiB;
constexpr size_t WS_Q = 140 * MiB, WS_K = 156 * MiB, WS_V = 172 * MiB, WS_P = 188 * MiB, WS_XBC = 244 * MiB, WS_Y = 268 * MiB, WS_S = 300 * MiB;
constexpr size_t WS_A2 = 140 * MiB;
constexpr size_t WS_END = 332 * MiB;
static_assert(WO_DOWN + (size_t)D * DFF * 2 <= W_LAYER && WS_W0 + DEPTH * W_LAYER <= WS_XG && WS_A2 + (size_t)M * DFF * 2 <= WS_XBC && WS_S + (size_t)BATCH * 32 * 4 * 2 * 8192 * 4 <= WS_END, "ws map");
constexpr int CW_BAR = 1024;
constexpr int CW_SCAN = 8192;

struct Params { const float* in[23]; float* out; unsigned char* ws; int ph_lo, ph_hi; };
enum { I_X = 0, I_POS, I_NMG, I_WIN, I_LQ1, I_LK1, I_LQ2, I_LK2, I_SUBG, I_SCW, I_SSDW, I_SSDB, I_DTB, I_ALOG, I_SSDD, I_SSDNG, I_WOUT, I_NFG, I_WUP, I_FCW, I_FCB, I_WDOWN, I_FNG };

__device__ __forceinline__ float bf2f(unsigned short h) { return __uint_as_float((unsigned)h << 16); }
__device__ __forceinline__ float bflo(unsigned w) { return __uint_as_float(w << 16); }
__device__ __forceinline__ float bfhi(unsigned w) { return __uint_as_float(w & 0xffff0000u); }
__device__ __forceinline__ void unpack8(u32x4 w, float* f) { f[0] = bflo(w.x); f[1] = bfhi(w.x); f[2] = bflo(w.y); f[3] = bfhi(w.y); f[4] = bflo(w.z); f[5] = bfhi(w.z); f[6] = bflo(w.w); f[7] = bfhi(w.w); }
__device__ __forceinline__ unsigned cvtpk(float lo, float hi) { return pg8::cvtpk(lo, hi); }
__device__ __forceinline__ u32x4 pack8f(const float* f) { u32x4 w; w.x = cvtpk(f[0], f[1]); w.y = cvtpk(f[2], f[3]); w.z = cvtpk(f[4], f[5]); w.w = cvtpk(f[6], f[7]); return w; }
__device__ __forceinline__ float silu_f(float v) { return v * __builtin_amdgcn_rcpf(1.0f + __expf(-v)); }
__device__ __forceinline__ float softplus_f(float v) { return fmaxf(v, 0.f) + log1pf(__expf(-fabsf(v))); }
__device__ __forceinline__ int crow(int r, int hi) { return (r & 3) + 8 * (r >> 2) + 4 * hi; }

__device__ __forceinline__ bf16x8 frag_row(const LAS char* img, int pitch, int row0, int k0, int lane) {
    return *(const LAS bf16x8*)(img + (row0 + (lane & 31)) * pitch + (k0 + 8 * (lane >> 5)) * 2);
}
__device__ __forceinline__ s16x4 tr4(const LAS char* p) { return __builtin_bit_cast(s16x4, __builtin_amdgcn_ds_read_tr16_b64_v4i16((LAS v4i16_t*)p)); }
__device__ __forceinline__ bf16x8 frag_tr_std(const LAS char* img, int pitch, int x0, int k0, int lane) {
    const int g = lane >> 4, i = lane & 15; const LAS char* p = img + (k0 + 8 * (g >> 1) + (i >> 2)) * pitch + (x0 + 16 * (g & 1) + 4 * (i & 3)) * 2;
    const s16x4 lo = tr4(p), hi = tr4(p + 4 * pitch);
    return (bf16x8){lo[0], lo[1], lo[2], lo[3], hi[0], hi[1], hi[2], hi[3]};
}
__device__ __forceinline__ bf16x8 frag_tr_perm(const LAS char* img, int pitch, int x0, int k0, int lane) {
    const int g = lane >> 4, i = lane & 15; const LAS char* p = img + (k0 + 4 * (g >> 1) + (i >> 2)) * pitch + (x0 + 16 * (g & 1) + 4 * (i & 3)) * 2;
    const s16x4 lo = tr4(p), hi = tr4(p + 8 * pitch);
    return (bf16x8){lo[0], lo[1], lo[2], lo[3], hi[0], hi[1], hi[2], hi[3]};
}
#define MFMA32(a, b, c) __builtin_amdgcn_mfma_f32_32x32x16_bf16((a), (b), (c), 0, 0, 0)

__device__ __forceinline__ void transpose_item(const float* W, int ldN, int k0, int n0, bf16* WT, int K, int dest_row0, LAS float* scr, int lane, const float* gk = nullptr) {
#pragma unroll 8
    for (int i = 0; i < 32; ++i) { const int kk = 2 * i + (lane >> 5); const float sc_ = gk ? gk[k0 + kk] : 1.0f; scr[kk * 33 + (lane & 31)] = sc_ * __builtin_nontemporal_load(W + (size_t)(k0 + kk) * ldN + n0 + (lane & 31)); }
    asm volatile("s_waitcnt lgkmcnt(0)" ::: "memory");
    const int c = lane & 7;
#pragma unroll
    for (int j = 0; j < 4; ++j) { const int n = (lane >> 3) + 8 * j; const LAS float* s = scr + (8 * c) * 33 + n;
        u32x4 o; o.x = cvtpk(s[0 * 33], s[1 * 33]); o.y = cvtpk(s[2 * 33], s[3 * 33]); o.z = cvtpk(s[4 * 33], s[5 * 33]); o.w = cvtpk(s[6 * 33], s[7 * 33]);
        *(u32x4*)(WT + (size_t)(dest_row0 + n0 + n) * K + k0 + 8 * c) = o; }
    asm volatile("s_waitcnt lgkmcnt(0)" ::: "memory");
}
__device__ __forceinline__ void convert_layer(const Params& p, int layer, LAS unsigned char* lds, int gw, int NGW, int wave, int lane) {
    LAS float* scr = (LAS float*)(lds + wave * 16384);
    unsigned char* wl = p.ws + WS_W0 + (size_t)layer * W_LAYER; bf16* WIN = (bf16*)(wl + WO_IN); bf16* WOUT = (bf16*)(wl + WO_OUT); bf16* WUP = (bf16*)(wl + WO_UP); bf16* WDOWN = (bf16*)(wl + WO_DOWN);
    constexpr int I_IN = 16 * 104, I_OUT = 16 * 32, I_UP = 16 * 176, I_DOWN = 44 * 32, NITEMS = I_IN + I_OUT + I_UP + I_DOWN;
    for (int it = gw; it < NITEMS; it += NGW) {
        int r = it;
        if (r < I_IN) { const int kb = r / 104, nb = r % 104; transpose_item(p.in[I_WIN] + (size_t)layer * D * IN_COLS, IN_COLS, 64 * kb, 32 * nb, WIN, D, 0, scr, lane, p.in[I_NMG] + layer * D); continue; } r -= I_IN;
        if (r < I_OUT) { const int kb = r / 32, nb = r % 32; transpose_item(p.in[I_WOUT] + (size_t)layer * D * D, D, 64 * kb, 32 * nb, WOUT, D, 0, scr, lane); continue; } r -= I_OUT;
        if (r < I_UP) { const int kb = r / 176, nb = r % 176; const int n0 = 32 * nb; const int nn = n0 < DFF ? n0 : n0 - DFF; const int drow = (nn >> 7) * 256 + (n0 < DFF ? 0 : 128) + (nn & 127);
            transpose_item(p.in[I_WUP] + (size_t)layer * D * UPW, UPW, 64 * kb, n0, WUP, D, drow - n0, scr, lane, p.in[I_NFG] + layer * D); continue; } r -= I_UP;
        { const int kb = r / 32, nb = r % 32; transpose_item(p.in[I_WDOWN] + (size_t)layer * DFF * D, D, 64 * kb, 32 * nb, WDOWN, DFF, 0, scr, lane); }
    }
}
__device__ __forceinline__ float inv_freq(int j) {
    switch (j) { case 0: return 1.0f; case 1: return 0.19392274f; case 2: return 0.03760603f; case 3: return 0.0072926646f; case 4: return 0.0014142136f; case 5: return 0.0002742482f; case 6: return 5.3182957e-05f; default: return 1.0313385e-05f; }
}

__device__ __forceinline__ void ssd1_unit(const Params& p, int layer, int b, int c, int g, LAS unsigned char* lds, int wave0) {
    unsigned mk_ = ~0u; asm volatile("" : "+s"(mk_)); int tid_raw = (int)__builtin_amdgcn_mbcnt_hi(mk_, __builtin_amdgcn_mbcnt_lo(mk_, 0u)); asm volatile("" : "+v"(tid_raw)); tid_raw += wave0 * 64; const int tid = tid_raw, wid = __builtin_amdgcn_readfirstlane(tid >> 6), lane = tid & 63, r32 = lane & 31, hi = lane >> 5;
    const int t0 = b * SEQ + c * 128;
    LAS char* XWF = (LAS char*)lds; LAS char* XWB = XWF + 40960; LAS char* BC = XWF + 81920; LAS float* sc = (LAS float*)(lds + 122880);
    const bf16* __restrict__ P = (const bf16*)(p.ws + WS_P); bf16* __restrict__ XBC = (bf16*)(p.ws + WS_XBC); const float* DT = (const float*)(p.ws + WS_DT);
    float* SSDV = (float*)(p.ws + WS_SSDV); float* CD = (float*)(p.ws + WS_CD); float* S = (float*)(p.ws + WS_S);
    if (tid < 256) { const int hh = tid >> 7, l = tid & 127, h = 2 * g + hh, t = t0 + l;
        const float dtf = softplus_f(DT[t * 8 + h] + p.in[I_DTB][layer * 8 + h]), dtb = softplus_f(DT[t * 8 + 4 + h] + p.in[I_DTB][layer * 8 + 4 + h]);
        const float A0 = -__expf(p.in[I_ALOG][layer * 8 + h]), A1 = -__expf(p.in[I_ALOG][layer * 8 + 4 + h]);
        sc[0 * 256 + tid] = dtf * A0 * LOG2E; sc[1 * 256 + tid] = dtb * A1 * LOG2E; sc[2 * 256 + tid] = dtf; sc[3 * 256 + tid] = dtb; }
    __syncthreads();
    if (wid < 4) { const int hh = wid >> 1, dir = wid & 1; LAS float* a = sc + dir * 256 + hh * 128;
        const float e0 = a[2 * lane], e1 = a[2 * lane + 1], ps = e0 + e1; float inc = ps;
#pragma unroll
        for (int o = 1; o < 64; o <<= 1) { const float tt = __builtin_bit_cast(float, __builtin_amdgcn_ds_bpermute((lane - o) << 2, __builtin_bit_cast(int, inc))); if (lane >= o) inc += tt; }
        const float exc = inc - ps, c0 = exc + e0, c1 = exc + ps, tot = __builtin_bit_cast(float, __builtin_amdgcn_readlane(__builtin_bit_cast(int, inc), 63));
        if (dir == 0) { sc[6 * 256 + hh * 128 + 2 * lane] = c0; sc[6 * 256 + hh * 128 + 2 * lane + 1] = c1; }
        else { sc[7 * 256 + hh * 128 + 2 * lane] = tot - c0 + e0; sc[7 * 256 + hh * 128 + 2 * lane + 1] = tot - c1 + e1; } }
    __syncthreads();
    if (tid < 256) { const int hh = tid >> 7, l = tid & 127, h = 2 * g + hh, t = t0 + l;
        const float fc = sc[6 * 256 + tid], rc = sc[7 * 256 + tid], dtf = sc[2 * 256 + tid], dtb = sc[3 * 256 + tid];
        const float ftot = sc[6 * 256 + hh * 128 + 127], rtot = sc[7 * 256 + hh * 128];
        sc[4 * 256 + tid] = __builtin_amdgcn_exp2f(ftot - fc) * dtf; sc[5 * 256 + tid] = __builtin_amdgcn_exp2f(rtot - rc) * dtb;
        *(f32x4*)(SSDV + ((size_t)t * 4 + h) * 4) = (f32x4){fc, rc, dtf, dtb};
        if (l == 0) { CD[((b * 32 + c) * 4 + h) * 2 + 0] = __builtin_amdgcn_exp2f(ftot); CD[((b * 32 + c) * 4 + h) * 2 + 1] = __builtin_amdgcn_exp2f(rtot); } }
    __syncthreads();
    const float* cw = p.in[I_SSDW] + (size_t)layer * 3 * 768; const float* cb = p.in[I_SSDB] + (size_t)layer * 768;
#pragma unroll 4
    for (int it = tid; it < 128 * 48; it += NTHREADS) {
        const int l = it / 48, cch = it % 48, seg = cch >> 4, cc = cch & 15, ch0 = seg * 256 + 128 * g + 8 * cc, s = c * 128 + l, t = t0 + l;
        const bf16* src = P + (size_t)t * 1792 + 1024 + ch0;
        u32x4 r0 = {0u, 0u, 0u, 0u}, r2 = r0; const u32x4 r1 = *(const u32x4*)src;
        if (s > 0) r0 = *(const u32x4*)(src - 1792); if (s < SEQ - 1) r2 = *(const u32x4*)(src + 1792);
        float x0[8], x1[8], x2[8], v[8]; unpack8(r0, x0); unpack8(r1, x1); unpack8(r2, x2);
        float w0[8], w1[8], w2[8], bb[8];
        *(f32x4*)&w0[0] = *(const f32x4*)(cw + ch0); *(f32x4*)&w0[4] = *(const f32x4*)(cw + ch0 + 4);
        *(f32x4*)&w1[0] = *(const f32x4*)(cw + 768 + ch0); *(f32x4*)&w1[4] = *(const f32x4*)(cw + 768 + ch0 + 4);
        *(f32x4*)&w2[0] = *(const f32x4*)(cw + 1536 + ch0); *(f32x4*)&w2[4] = *(const f32x4*)(cw + 1536 + ch0 + 4);
        *(f32x4*)&bb[0] = *(const f32x4*)(cb + ch0); *(f32x4*)&bb[4] = *(const f32x4*)(cb + ch0 + 4);
#pragma unroll
        for (int j = 0; j < 8; ++j) v[j] = silu_f(bb[j] + w0[j] * x0[j] + w1[j] * x1[j] + w2[j] * x2[j]);
        *(u32x4*)(XBC + (size_t)t * 768 + ch0) = pack8f(v);
        if (seg == 0) { const int hh = cc >> 3; const float wf = sc[4 * 256 + hh * 128 + l], wb = sc[5 * 256 + hh * 128 + l]; float vf[8], vb[8];
#pragma unroll
            for (int j = 0; j < 8; ++j) { vf[j] = v[j] * wf; vb[j] = v[j] * wb; }
            *(LAS u32x4*)(XWF + l * 320 + cc * 16) = pack8f(vf); *(LAS u32x4*)(XWB + l * 320 + cc * 16) = pack8f(vb); }
        else if (seg == 1) { *(LAS u32x4*)(BC + l * 320 + cc * 16) = pack8f(v); }
    }
    __syncthreads();
    { const int dir = wid >> 2, hh = (wid >> 1) & 1, pt = wid & 1, h = 2 * g + hh; const LAS char* img = dir ? XWB : XWF;
        f32x16 acc[4] = {};
#pragma unroll
        for (int kk = 0; kk < 8; ++kk) { const bf16x8 A = frag_tr_std(img, 320, 64 * hh + 32 * pt, 16 * kk, lane);
#pragma unroll
            for (int nt = 0; nt < 4; ++nt) { const bf16x8 B = frag_tr_std(BC, 320, 32 * nt, 16 * kk, lane); acc[nt] = MFMA32(A, B, acc[nt]); } }
        float* Sp = S + ((size_t)(((b * 32 + c) * 4 + h) * 2 + dir)) * 8192;
#pragma unroll
        for (int nt = 0; nt < 4; ++nt)
#pragma unroll
            for (int r = 0; r < 16; ++r) Sp[(32 * pt + crow(r, hi)) * 128 + 32 * nt + r32] = acc[nt][r];
    }
    __syncthreads();
}

__device__ __forceinline__ void ssd3_unit(const Params& p, int layer, int b, int c, int g, LAS unsigned char* lds, int wave0) {
    unsigned mk_ = ~0u; asm volatile("" : "+s"(mk_)); int tid_raw = (int)__builtin_amdgcn_mbcnt_hi(mk_, __builtin_amdgcn_mbcnt_lo(mk_, 0u)); asm volatile("" : "+v"(tid_raw)); tid_raw += wave0 * 64; const int tid = tid_raw, wid = __builtin_amdgcn_readfirstlane(tid >> 6), lane = tid & 63, r32 = lane & 31, hi = lane >> 5;
    const int t0 = b * SEQ + c * 128;
    LAS float* sc = (LAS float*)lds; LAS char* CI = (LAS char*)lds + 8192; LAS char* XS = CI + 34816; LAS char* BI = XS + 40960; LAS char* HI = BI;
    const bf16* P = (const bf16*)(p.ws + WS_P); const bf16* XBC = (const bf16*)(p.ws + WS_XBC); const float* SSDV = (const float*)(p.ws + WS_SSDV);
    const float* S = (const float*)(p.ws + WS_S); bf16* Y = (bf16*)(p.ws + WS_Y);
    f32x4 hreg[16];
    { const float* Sb = S + ((size_t)((b * 32 + c) * 4 + 2 * g) * 2) * 8192;
#pragma unroll
        for (int i = 0; i < 16; ++i) { const int idx = tid + NTHREADS * i; hreg[i] = *(const f32x4*)(Sb + (size_t)(idx >> 11) * 8192 + (idx & 2047) * 4); } }
#pragma unroll 6
    for (int it = tid; it < 128 * 48; it += NTHREADS) {
        const int l = it / 48, cch = it % 48, seg = cch >> 4, cc = cch & 15;
        const u32x4 v = *(const u32x4*)(XBC + (size_t)(t0 + l) * 768 + seg * 256 + 128 * g + 8 * cc);
        if (seg == 0) *(LAS u32x4*)(XS + l * 320 + cc * 16) = v; else if (seg == 1) *(LAS u32x4*)(BI + l * 272 + cc * 16) = v; else *(LAS u32x4*)(CI + l * 272 + cc * 16) = v;
    }
    if (tid < 256) { const int hh = tid >> 7, l = tid & 127, h = 2 * g + hh; const f32x4 sv = *(const f32x4*)(SSDV + ((size_t)(t0 + l) * 4 + h) * 4);
        sc[0 * 256 + tid] = sv[0]; sc[1 * 256 + tid] = sv[1]; sc[2 * 256 + tid] = sv[0] - __log2f(sv[2]); sc[3 * 256 + tid] = sv[1] - __log2f(sv[3]); }
    __syncthreads();
    const int lb = wid & 3, hh = wid >> 2, h = 2 * g + hh;
    f32x16 X[4] = {};
#pragma unroll
    for (int kk = 0; kk < 8; ++kk) { const bf16x8 Bf = frag_row(CI, 272, 32 * lb, 16 * kk, lane);
#pragma unroll
        for (int st = 0; st < 4; ++st) { const bf16x8 Af = frag_row(BI, 272, 32 * st, 16 * kk, lane); X[st] = MFMA32(Af, Bf, X[st]); } }
    __syncthreads();
    {
#pragma unroll
        for (int i = 0; i < 16; ++i) { const int idx = tid + NTHREADS * i, img = idx >> 11, e = (idx & 2047) * 4, pp = e >> 7, n = e & 127;
            u32x2 w; w.x = cvtpk(hreg[i][0], hreg[i][1]); w.y = cvtpk(hreg[i][2], hreg[i][3]);
            *(LAS u32x2*)(HI + img * 17408 + pp * 272 + n * 2) = w; } }
    __syncthreads();
    const int l = 32 * lb + r32; const float fl = sc[0 * 256 + hh * 128 + l], rl = sc[1 * 256 + hh * 128 + l]; const float Dh = p.in[I_SSDD][layer * 4 + h];
    f32x16 y[2] = {};
#pragma unroll
    for (int st = 0; st < 4; ++st) {
        bf16x8 wfr[2];
#pragma unroll
        for (int ss = 0; ss < 2; ++ss) { unsigned w[4];
#pragma unroll
            for (int jj = 0; jj < 4; ++jj) { float val[2];
#pragma unroll
                for (int q = 0; q < 2; ++q) { const int r = 8 * ss + 2 * jj + q, s = 32 * st + crow(r, hi);
                    const float ef = sc[2 * 256 + hh * 128 + s], eb = sc[3 * 256 + hh * 128 + s];
                    const float f1 = __builtin_amdgcn_exp2f(fl - ef), f2 = __builtin_amdgcn_exp2f(rl - eb);
                    const float fac = (s <= l ? f1 : 0.f) + (s >= l ? f2 : 0.f);
                    val[q] = X[st][r] * fac + (s == l ? Dh : 0.f); }
                w[jj] = cvtpk(val[0], val[1]); }
            const u32x4 ww = {w[0], w[1], w[2], w[3]}; wfr[ss] = __builtin_bit_cast(bf16x8, ww); }
#pragma unroll
        for (int ss = 0; ss < 2; ++ss)
#pragma unroll
            for (int pt = 0; pt < 2; ++pt) { const bf16x8 Af = frag_tr_perm(XS, 320, 64 * hh + 32 * pt, 32 * st + 16 * ss, lane); y[pt] = MFMA32(Af, wfr[ss], y[pt]); }
    }
#pragma unroll
    for (int dir = 0; dir < 2; ++dir) { f32x16 yo[2] = {};
#pragma unroll
        for (int kk = 0; kk < 8; ++kk) { const bf16x8 Bf = frag_row(CI, 272, 32 * lb, 16 * kk, lane);
#pragma unroll
            for (int pt = 0; pt < 2; ++pt) { const bf16x8 Af = frag_row(HI + (hh * 2 + dir) * 17408, 272, 32 * pt, 16 * kk, lane); yo[pt] = MFMA32(Af, Bf, yo[pt]); } }
        const float el = __builtin_amdgcn_exp2f(dir ? rl : fl);
#pragma unroll
        for (int pt = 0; pt < 2; ++pt)
#pragma unroll
            for (int r = 0; r < 16; ++r) y[pt][r] += el * yo[pt][r];
    }
    const size_t t = (size_t)t0 + l; float ssq = 0.f;
#pragma unroll
    for (int pt = 0; pt < 2; ++pt)
#pragma unroll
        for (int q4 = 0; q4 < 4; ++q4) { const int pp = 32 * pt + 8 * q4 + 4 * hi; const u32x2 zz = *(const u32x2*)(P + t * 1792 + 768 + 128 * g + 64 * hh + pp);
            const float z0 = bflo(zz.x), z1 = bfhi(zz.x), z2 = bflo(zz.y), z3 = bfhi(zz.y);
            y[pt][4 * q4 + 0] *= silu_f(z0); y[pt][4 * q4 + 1] *= silu_f(z1); y[pt][4 * q4 + 2] *= silu_f(z2); y[pt][4 * q4 + 3] *= silu_f(z3);
#pragma unroll
            for (int q = 0; q < 4; ++q) ssq += y[pt][4 * q4 + q] * y[pt][4 * q4 + q]; }
    ssq = lx_sum32(ssq);
    if (hi == 0) sc[4 * 256 + hh * 128 + l] = ssq;
    __syncthreads();
    const float tot = sc[4 * 256 + l] + sc[4 * 256 + 128 + l]; const float rstd = __builtin_amdgcn_rsqf(tot * (1.0f / 128.0f) + 1e-5f);
    const float* ng = p.in[I_SSDNG] + layer * 256 + 128 * g + 64 * hh;
#pragma unroll
    for (int pt = 0; pt < 2; ++pt)
#pragma unroll
        for (int q4 = 0; q4 < 4; ++q4) { const int pp = 32 * pt + 8 * q4 + 4 * hi; const f32x4 gg = *(const f32x4*)(ng + pp);
            u32x2 w; w.x = cvtpk(y[pt][4 * q4 + 0] * rstd * gg[0], y[pt][4 * q4 + 1] * rstd * gg[1]); w.y = cvtpk(y[pt][4 * q4 + 2] * rstd * gg[2], y[pt][4 * q4 + 3] * rstd * gg[3]);
            *(u32x2*)(Y + t * 1024 + 768 + 128 * g + 64 * hh + pp) = w; }
    __syncthreads();
}
#ifndef N_LAUNCH_MODE
#define N_LAUNCH_MODE 1
#endif
#ifndef PHASE_MASK
#define PHASE_MASK 0xFFFF
#endif
#define PEN(i) ((PHASE_MASK >> (i)) & 1)
#ifndef REP_CVT
#define REP_CVT 1
#endif
#ifndef REP_IN
#define REP_IN 1
#endif
#ifndef REP_MIXA
#define REP_MIXA 1
#endif
#ifndef REP_ATT
#define REP_ATT 1
#endif
#ifndef REP_MIXC
#define REP_MIXC 1
#endif
#ifndef REP_UP
#define REP_UP 1
#endif
constexpr int PH_PRO = 0, PH_PER_LAYER = 7, PH_FINAL = 1 + PH_PER_LAYER * DEPTH, NPH = PH_FINAL + 1;
enum { LP_IN = 0, LP_MIXA, LP_MIXB, LP_MIXC, LP_OUT, LP_UP, LP_DOWN };

__global__ void __launch_bounds__(NTHREADS, 2) fwd_kernel(Params p) {
    extern __shared__ __attribute__((aligned(16))) unsigned char lds_raw[];
    LAS unsigned char* lds = (LAS unsigned char*)lds_raw;
    const int G = gridDim.x, bx = blockIdx.x, vcu = (G % 8 == 0) ? (bx % 8) * (G / 8) + bx / 8 : bx;
    const int NGW = G * NWAVES, NGT = G * NTHREADS;
    const int wave0 = __builtin_amdgcn_readfirstlane(threadIdx.x >> 6);
#define LOCALS unsigned mk_ = ~0u; asm volatile("" : "+s"(mk_)); int tid_r = (int)__builtin_amdgcn_mbcnt_hi(mk_, __builtin_amdgcn_mbcnt_lo(mk_, 0u)); asm volatile("" : "+v"(tid_r)); tid_r += wave0 * 64; const int tid = tid_r, lane = tid & 63, wave = __builtin_amdgcn_readfirstlane(tid >> 6), gw = vcu * NWAVES + wave, gtid = vcu * NTHREADS + tid; (void)lane; (void)gw; (void)gtid;
    volatile LAS unsigned* MISC = (volatile LAS unsigned*)(lds + LDSCTL_OFF);
    { LOCALS for (int u = tid; u < (LDS_BYTES - LDSCTL_OFF) / 4; u += NTHREADS) ((LAS unsigned*)(lds + LDSCTL_OFF))[u] = 0u; }
    __syncthreads();
    unsigned* ctl = (unsigned*)(p.ws + WS_CTL);
    const bool multi = (p.ph_hi - p.ph_lo) > 1;
    XcdBarrier bar; bar.w0 = wave0; bar.bar = ctl + CW_BAR; bar.x = 0; bar.st = nullptr;
#if N_LAUNCH_MODE == 0
    if (multi) bar = xcd_barrier_post(ctl + CW_BAR, MISC + 8, wave0);
#endif
#define IN(k) (p.ph_lo <= (k) && (k) < p.ph_hi)
#define SEAM(k) do { if (p.ph_lo <= (k) && (k) + 1 < p.ph_hi) xcd_barrier(bar); } while (0)

#define XO (p.out)
#define XG ((bf16*)(p.ws + WS_XG))
#define RSS ((float*)(p.ws + WS_RSS))
#define COS ((float*)(p.ws + WS_COS))
#define SIN ((float*)(p.ws + WS_SIN))
#define Qb ((bf16*)(p.ws + WS_Q))
#define Kb ((bf16*)(p.ws + WS_K))
#define Vb ((bf16*)(p.ws + WS_V))
#define Pb ((bf16*)(p.ws + WS_P))
#define Yb ((bf16*)(p.ws + WS_Y))
#define DT ((float*)(p.ws + WS_DT))
#define A2 ((bf16*)(p.ws + WS_A2))
#define WIN ((bf16*)(p.ws + WS_W0 + (size_t)layer * W_LAYER + WO_IN))
#define WOUT ((bf16*)(p.ws + WS_W0 + (size_t)layer * W_LAYER + WO_OUT))
#define WUP ((bf16*)(p.ws + WS_W0 + (size_t)layer * W_LAYER + WO_UP))
#define WDOWN ((bf16*)(p.ws + WS_W0 + (size_t)layer * W_LAYER + WO_DOWN))

    if (PEN(0) && IN(PH_PRO)) { LOCALS
#if N_LAUNCH_MODE != 0
        if (bx == 0) for (int u = tid; u < (int)(CTL_ZERO_BYTES / 4); u += NTHREADS) ctl[u] = 0u;
#endif
        const int* pos = (const int*)p.in[I_POS];
        for (int i = gtid; i < M * 8; i += NGT) { const int row = i >> 3, j = i & 7; const float ang = (float)pos[row] * inv_freq(j);
            const double rev = (double)ang * 0.15915494309189535; const double fr = rev - __builtin_rint(rev); const float a = (float)(fr * 6.283185307179586);
            COS[i] = cosf(a); SIN[i] = sinf(a); }
        for (int rep = 0; rep < REP_CVT; ++rep) convert_layer(p, 0, lds, gw, NGW, wave, lane);
        __syncthreads();
        for (int m = gw; m < M; m += NGW) { const f32x4* xr = (const f32x4*)(p.in[I_X] + (size_t)m * D) + lane; float ss = 0.f; u32x2* o8 = (u32x2*)(XG + (size_t)m * D) + lane;
#pragma unroll
            for (int j = 0; j < 4; ++j) { const f32x4 v = xr[64 * j]; ss += (v[0] * v[0] + v[1] * v[1]) + (v[2] * v[2] + v[3] * v[3]);
                u32x2 w; w.x = cvtpk(v[0], v[1]); w.y = cvtpk(v[2], v[3]); o8[64 * j] = w; }
            ss = wave_sum(ss); if (lane < 16) RSS[(size_t)m * 16 + lane] = lane == 0 ? ss : 0.f; }
    }
    if (multi && p.ph_lo <= PH_PRO && PH_PRO + 1 < p.ph_hi) cg::this_grid().sync();
#if N_LAUNCH_MODE != 0
    if (multi) bar = xcd_barrier_post(ctl + CW_BAR, MISC + 8, wave0);
#endif

    for (int layer = 0; layer < DEPTH; ++layer) {
        const int pb = 1 + PH_PER_LAYER * layer;
        const float lam_init = layer == 0 ? 0.2f : layer == 1 ? 0.35550906759f : layer == 2 ? 0.47071301834f : 0.55605820416f;
        if (PEN(2) && IN(pb + LP_IN)) {
            { LOCALS
            if (bx == 0 && tid < 32) ((unsigned*)(p.ws + WS_KMAX))[tid] = 0u;
            {
                const float* wsrc = p.in[I_WIN] + (size_t)layer * D * IN_COLS + IN_MAIN; float w[16][8];
#pragma unroll
                for (int i = 0; i < 16; ++i) { const float gk_ = p.in[I_NMG][layer * D + 16 * lane + i]; const f32x4 a = *(const f32x4*)(wsrc + (size_t)(16 * lane + i) * IN_COLS) * gk_, b = *(const f32x4*)(wsrc + (size_t)(16 * lane + i) * IN_COLS + 4) * gk_;
                    w[i][0] = a[0]; w[i][1] = a[1]; w[i][2] = a[2]; w[i][3] = a[3]; w[i][4] = b[0]; w[i][5] = b[1]; w[i][6] = b[2]; w[i][7] = b[3]; }
                for (int m = gw; m < M; m += NGW) { const u32x4 a = *(const u32x4*)(XG + (size_t)m * D + 16 * lane), b = *(const u32x4*)(XG + (size_t)m * D + 16 * lane + 8);
                    float xv[16]; unpack8(a, xv); unpack8(b, xv + 8); float acc[8];
#pragma unroll
                    for (int j = 0; j < 8; ++j) acc[j] = 0.f;
#pragma unroll
                    for (int i = 0; i < 16; ++i)
#pragma unroll
                        for (int j = 0; j < 8; ++j) acc[j] += xv[i] * w[i][j];
                    float s = lane < 16 ? RSS[(size_t)m * 16 + lane] : 0.f; s = wave_sum(s); const float rs = __builtin_amdgcn_rsqf(s * (1.0f / 1024.0f) + 1e-5f);
                    float outv = 0.f;
#pragma unroll
                    for (int j = 0; j < 8; ++j) { const float t = wave_sum(acc[j]); if (lane == j) outv = t; }
                    if (lane < 8) DT[(size_t)m * 8 + lane] = outv * rs; }
            } }
            pg8::Gemm g{XG, WIN, M, IN_MAIN, D}; pg8::StaticOrder S; S.init(M, IN_MAIN, G, bx);
            pg8::EpiIn E{RSS, COS, SIN, Qb, Kb, Vb, Pb};
            const int nfull = (64 * 13) % G, nidle = G - nfull;
            if (layer + 1 < DEPTH && nidle > 0 && nfull > 0) { if (bx >= nfull) { LOCALS convert_layer(p, layer + 1, lds, (bx - nfull) * NWAVES + wave, nidle * NWAVES, wave, lane); } __syncthreads(); }
            for (int rep = 0; rep < REP_IN; ++rep) pg8::gemm_phase<pg8::EpiIn, pg8::StaticOrder, true, true>(lds, g, S, E, wave0);
            if (layer + 1 < DEPTH && !(nidle > 0 && nfull > 0)) { { LOCALS convert_layer(p, layer + 1, lds, gw, NGW, wave, lane); } __syncthreads(); }
        }
        SEAM(pb + LP_IN);
        if (PEN(3) && IN(pb + LP_MIXA)) { LOCALS
            {
                unsigned* KMAX = (unsigned*)(p.ws + WS_KMAX); LAS float* red = (LAS float*)(lds + 155648);
                for (int i0 = vcu * NTHREADS; i0 < M * 8; i0 += NGT) { const int i = i0 + tid, t = i >> 3, hc = i & 7; const bf16* kp = Kb + (size_t)t * 512 + hc * 64; float ss = 0.f;
#pragma unroll
                    for (int j = 0; j < 8; ++j) { float f[8]; unpack8(*(const u32x4*)(kp + 8 * j), f);
#pragma unroll
                        for (int e = 0; e < 8; ++e) ss += f[e] * f[e]; }
                    ss = fmaxf(ss, lx_get(ss, lane, 8)); ss = fmaxf(ss, lx_get(ss, lane, 16)); ss = lx_max32(ss);
                    if (lane < 8) red[wave * 8 + lane] = ss;
                    __syncthreads();
                    if (tid < 8) { float m = red[tid];
#pragma unroll
                        for (int w = 1; w < 8; ++w) m = fmaxf(m, red[w * 8 + tid]);
                        atomicMax(KMAX + (i0 >> 15) * 8 + tid, __float_as_uint(m)); }
                    __syncthreads(); }
            }
            for (int rep = 0; rep < REP_MIXA; ++rep) for (int u = vcu; u < 256; u += G) ssd1_unit(p, layer, u >> 6, (u >> 1) & 31, u & 1, lds, wave0);
            const float* scw = p.in[I_SCW] + (size_t)layer * 3 * 256;
            const bf16* __restrict__ Pr_ = Pb; bf16* __restrict__ Yr_ = Yb;
#pragma unroll 4
            for (int it = gtid; it < M * 32; it += NGT) { const int t = it >> 5, cc = it & 31, s = t & (SEQ - 1); const bf16* src = Pr_ + (size_t)t * 1792 + 8 * cc;
                float bv[8], c0[8], c1[8], c2[8], h0[8], h1[8], h2[8], o[8]; const u32x4 z4 = {0u, 0u, 0u, 0u};
                unpack8(*(const u32x4*)src, bv); unpack8(*(const u32x4*)(src + 256), c1); unpack8(*(const u32x4*)(src + 512), h1);
                unpack8(s > 0 ? *(const u32x4*)(src - 1792 + 256) : z4, c0); unpack8(s > 0 ? *(const u32x4*)(src - 1792 + 512) : z4, h0);
                unpack8(s < SEQ - 1 ? *(const u32x4*)(src + 1792 + 256) : z4, c2); unpack8(s < SEQ - 1 ? *(const u32x4*)(src + 1792 + 512) : z4, h2);
#pragma unroll
                for (int j = 0; j < 8; ++j) o[j] = bv[j] * (scw[8 * cc + j] * (c0[j] * h0[j]) + scw[256 + 8 * cc + j] * (c1[j] * h1[j]) + scw[512 + 8 * cc + j] * (c2[j] * h2[j]));
                *(u32x4*)(Yr_ + (size_t)t * 1024 + 512 + 8 * cc) = pack8f(o); }
        }
        SEAM(pb + LP_MIXA);
        if (PEN(4) && IN(pb + LP_MIXB)) {
            { LOCALS float* S = (float*)(p.ws + WS_S); const float* CD = (const float*)(p.ws + WS_CD);
                for (int i = gtid; i < 32 * 4096; i += NGT) { const int bhd = i >> 12, e = (i & 4095) * 2, b = bhd >> 3, h = (bhd >> 1) & 3, dir = bhd & 1;
                    typedef float f32x2_ __attribute__((ext_vector_type(2)));
                    f32x2_ st[32]; float dec[32]; const int cmask = dir ? 31 : 0;
#pragma unroll
                    for (int cc = 0; cc < 32; ++cc) { const int c = cc ^ cmask; st[cc] = *(const f32x2_*)(S + ((size_t)(((b * 32 + c) * 4 + h) * 2 + dir)) * 8192 + e); dec[cc] = CD[((b * 32 + c) * 4 + h) * 2 + dir]; }
                    float z0_ = 0.f; asm volatile("" : "+v"(z0_)); f32x2_ hs = {z0_, z0_};
#pragma unroll
                    for (int cc = 0; cc < 32; ++cc) { const int c = cc ^ cmask; *(f32x2_*)(S + ((size_t)(((b * 32 + c) * 4 + h) * 2 + dir)) * 8192 + e) = hs; hs = hs * dec[cc] + st[cc]; } } }
            asm volatile("s_waitcnt vmcnt(0)" ::: "memory");
            __syncthreads();
            if (multi && wave0 == 0 && xb_lane0()) { __builtin_amdgcn_fence(__ATOMIC_RELEASE, "agent"); asm volatile("s_waitcnt vmcnt(0)" ::: "memory"); (void)xb_add(ctl + CW_SCAN + layer, 1u); }
            float lam;
            { LOCALS const float a = wave_sum(p.in[I_LQ1][layer * 64 + lane] * p.in[I_LK1][layer * 64 + lane]), b2 = wave_sum(p.in[I_LQ2][layer * 64 + lane] * p.in[I_LK2][layer * 64 + lane]);
                lam = __builtin_bit_cast(float, __builtin_amdgcn_readfirstlane(__builtin_bit_cast(int, __expf(a) - __expf(b2) + lam_init))); }
#define ATT_UNIT(UID) do { const int uid_ = (UID), b = uid_ >> 6, h = (uid_ >> 4) & 3, qb = uid_ & 15; \
                attn::attn_unit2(Qb, Kb, Vb, Yb, b, h, qb * 256, lam, lam_init_s, p.in[I_SUBG] + layer * 128, (const unsigned*)(p.ws + WS_KMAX), (attn::lchar*)lds, wave0); } while (0)
            const float lam_init_s = __builtin_bit_cast(float, __builtin_amdgcn_readfirstlane(__builtin_bit_cast(int, lam_init)));
            for (int rep = 0; rep < REP_ATT; ++rep) {
                if (G >= 256) { if (vcu < 256) ATT_UNIT(vcu); }
                else for (int uid = vcu; uid < 256; uid += G) ATT_UNIT(uid); }
#undef ATT_UNIT
        }
        if (!multi) SEAM(pb + LP_MIXB);
        else if (IN(pb + LP_MIXB) && IN(pb + LP_MIXC)) {
            if (wave0 == 0 && xb_lane0()) { unsigned* sc_ = ctl + CW_SCAN + layer; XB_SPIN(xb_ld(sc_) < (unsigned)G, bar.bar); __builtin_amdgcn_fence(__ATOMIC_ACQUIRE, "agent"); asm volatile("s_waitcnt vmcnt(0)" ::: "memory"); }
            __syncthreads(); }
        if (PEN(5) && IN(pb + LP_MIXC)) { for (int rep = 0; rep < REP_MIXC; ++rep) for (int u = vcu; u < 256; u += G) ssd3_unit(p, layer, u >> 6, (u >> 1) & 31, u & 1, lds, wave0); }
        SEAM(pb + LP_MIXC);
        if (PEN(6) && IN(pb + LP_OUT)) {
            pg8::Gemm g{Yb, WOUT, M, D, D}; pg8::StaticOrder S; S.init(M, D, G, bx);
            pg8::EpiRes E{XG, RSS};
            pg8::gemm_phase<pg8::EpiRes, pg8::StaticOrder, true, true>(lds, g, S, E, wave0);
        }
        SEAM(pb + LP_OUT);
        if (PEN(7) && IN(pb + LP_UP)) {
            pg8::Gemm g{XG, WUP, 68 * 256, UPW, D}; pg8::StaticOrder S; S.init(68 * 256, UPW, G, bx);
            pg8::EpiUpConv E{RSS, p.in[I_FCW] + (size_t)layer * 3 * UPW, p.in[I_FCB] + (size_t)layer * UPW, A2, (LAS float*)(lds + 147456), (LAS float*)(lds + 131072)};
            for (int rep = 0; rep < REP_UP; ++rep) pg8::gemm_phase<pg8::EpiUpConv, pg8::StaticOrder, true, true, 1>(lds, g, S, E, wave0);
        }
        SEAM(pb + LP_UP);
        if (PEN(9) && IN(pb + LP_DOWN)) {
            pg8::Gemm g{A2, WDOWN, M, D, DFF}; pg8::StaticOrder S; S.init(M, D, G, bx);
            pg8::EpiRes E{XG, RSS};
            pg8::gemm_phase<pg8::EpiRes, pg8::StaticOrder, true, true>(lds, g, S, E, wave0);
        }
        SEAM(pb + LP_DOWN);
    }
    if (PEN(10) && IN(PH_FINAL)) { LOCALS
        const float* gf = p.in[I_FNG];
        for (int m = gw; m < M; m += NGW) { float s = lane < 16 ? RSS[(size_t)m * 16 + lane] : 0.f; s = wave_sum(s); const float rs = __builtin_amdgcn_rsqf(s * (1.0f / 1024.0f) + 1e-5f);
            const u32x2* xr = (const u32x2*)(XG + (size_t)m * D) + lane; f32x4* orow = (f32x4*)(XO + (size_t)m * D) + lane;
#pragma unroll
            for (int j = 0; j < 4; ++j) { const u32x2 w = xr[64 * j]; const f32x4 v = {bflo(w.x), bfhi(w.x), bflo(w.y), bfhi(w.y)}; const f32x4 gg = *((const f32x4*)gf + lane + 64 * j); orow[64 * j] = v * gg * rs; } }
    }
#undef IN
#undef SEAM
}

__global__ void fill_kernel(float* o, int n, float v) { for (int i = blockIdx.x * blockDim.x + threadIdx.x; i < n; i += gridDim.x * blockDim.x) o[i] = v; }

extern "C" void kernel_launch(void* const* d_in, const int* in_sizes, int n_in, void* d_out, int out_size, void* d_ws, size_t ws_size, hipStream_t stream) {
    static int grid = 0;
    if (grid == 0) {
        if (n_in != 23 || in_sizes[0] != M * D || out_size != M * D || ws_size < WS_END) {
            fprintf(stderr, "kernel_launch: unexpected shapes / workspace: n_in %d in0 %d out %d ws %zu (need %zu)\n", n_in, n_in > 0 ? in_sizes[0] : -1, out_size, ws_size, (size_t)WS_END);
            grid = -1;
        } else {
            int dev = 0, cus = 0, per_cu = 0;
            hipGetDevice(&dev); hipDeviceGetAttribute(&cus, hipDeviceAttributeMultiprocessorCount, dev);
            hipFuncSetAttribute((const void*)fwd_kernel, hipFuncAttributeMaxDynamicSharedMemorySize, LDS_BYTES);
            hipOccupancyMaxActiveBlocksPerMultiprocessor(&per_cu, (const void*)fwd_kernel, NTHREADS, LDS_BYTES);
            (void)hipGetLastError();
            if (per_cu < 1) { fprintf(stderr, "kernel_launch: occupancy query reports %d blocks per CU\n", per_cu); grid = -1; }
            else grid = cus;
        }
    }
    if (grid < 0) { hipLaunchKernelGGL(fill_kernel, dim3(256), dim3(256), 0, stream, (float*)d_out, out_size, 1.0e30f); return; }
#if N_LAUNCH_MODE == 0
    hipMemsetAsync((char*)d_ws + WS_CTL, 0, CTL_ZERO_BYTES, stream);
#endif
    Params a{};
    for (int i = 0; i < 23; ++i) a.in[i] = (const float*)d_in[i];
    a.out = (float*)d_out; a.ws = (unsigned char*)d_ws;
#if N_LAUNCH_MODE == 0
    for (int ph = 0; ph < NPH; ++ph) { a.ph_lo = ph; a.ph_hi = ph + 1; hipLaunchKernelGGL(fwd_kernel, dim3(grid), dim3(NTHREADS), LDS_BYTES, stream, a); }
#else
    a.ph_lo = 0; a.ph_hi = NPH; void* args[] = {&a};
    hipError_t e = hipLaunchCooperativeKernel((const void*)fwd_kernel, dim3(grid), dim3(NTHREADS), args, LDS_BYTES, stream);
    if (e != hipSuccess) fprintf(stderr, "cooperative launch failed: %s (grid %d)\n", hipGetErrorString(e), grid);
#endif
}
```

```cpp
#include <hip/hip_runtime.h>
#include <hip/hip_cooperative_groups.h>
#include <cstdio>
#include <cstdint>
namespace cg = cooperative_groups;
__device__ __forceinline__ float lx_get(float v, int lane, int o) { return __builtin_bit_cast(float, __builtin_amdgcn_ds_bpermute((lane ^ o) << 2, __builtin_bit_cast(int, v))); }
__device__ __forceinline__ float lx_sum32(float v) { const unsigned a = __builtin_bit_cast(unsigned, v); auto r = __builtin_amdgcn_permlane32_swap(a, a, false, false); const unsigned r0 = r[0], r1 = r[1]; return __builtin_bit_cast(float, r0) + __builtin_bit_cast(float, r1); }
__device__ __forceinline__ float lx_max32(float v) { const unsigned a = __builtin_bit_cast(unsigned, v); auto r = __builtin_amdgcn_permlane32_swap(a, a, false, false); const unsigned r0 = r[0], r1 = r[1]; return fmaxf(__builtin_bit_cast(float, r0), __builtin_bit_cast(float, r1)); }
#define LX_DPP(v, ctrl) __builtin_bit_cast(float, __builtin_amdgcn_update_dpp(0, __builtin_bit_cast(int, (v)), (ctrl), 0xf, 0xf, false))
__device__ __forceinline__ float wave_sum_l(float v, int lane) {
#pragma unroll
    for (int o = 1; o < 32; o <<= 1) v += lx_get(v, lane, o);
    return lx_sum32(v);
}
#define wave_sum(v) wave_sum_l((v), lane)

namespace pg8 {
#define PG8_LAS __attribute__((address_space(3)))
typedef unsigned short bf16_t;
typedef short bf16x8 __attribute__((ext_vector_type(8)));
typedef float f32x4 __attribute__((ext_vector_type(4)));
typedef unsigned u32x4 __attribute__((ext_vector_type(4)));
constexpr int BM = 256, BK = 64, HALF = 128, HTB = HALF * BK * 2  , STAGE_BYTES = 8 * HTB, NXCD = 8, WGM = 8;

__host__ __device__ __forceinline__ int lds_byte(int r, int c) { const int st = (r >> 4) * 2 + (c >> 5), rr = r & 15, cc = c & 31, ob = rr * 64 + cc * 2; return st * 1024 + (ob ^ (((ob >> 9) & 1) << 5)); }
__host__ __device__ __forceinline__ void stage_rc(int b, int& R, int& C) { const int st = b / 1024, sb = b % 1024, swz = sb ^ (((sb >> 9) & 1) << 5); R = (st >> 1) * 16 + swz / 64; C = (st & 1) * 32 + (swz % 64) / 2; }
__host__ __device__ __forceinline__ int perm32(int rho) { const int n = rho >> 4, i = rho & 15; return 8 * (i >> 2) + 4 * n + (i & 3); }

struct Unit { int pm, pn; };
struct Gemm { const bf16_t* A; const bf16_t* Bt; int M, N, K; };

struct StaticOrder {
    int nM, nN, nwg, G, c;
    __host__ __device__ void init(int M, int N, int G_, int c_) { nM = M / BM; nN = N / BM; nwg = nM * nN; G = G_; c = c_; }
    __host__ __device__ bool next(int i, Unit& u) const {
        const int L = i * G + c; if (L >= nwg) return false;
        int wgid = L; { const int q = nwg / NXCD, r = nwg % NXCD, xcd = wgid % NXCD, off = wgid / NXCD; wgid = (xcd < r ? xcd * (q + 1) : r * (q + 1) + (xcd - r) * q) + off; }
        const int nig = WGM * nN, gid = wgid / nig, fm = gid * WGM, gsz = (nM - fm) < WGM ? (nM - fm) : WGM;
        u.pm = fm + ((wgid % nig) % gsz); u.pn = (wgid % nig) / gsz; return true;
    }
    __device__ __forceinline__ void a_ready(const Unit&) const {}
    __device__ __forceinline__ void done(const Unit&) const {}
};

typedef unsigned u32x2 __attribute__((ext_vector_type(2)));
typedef float f32x2_t __attribute__((ext_vector_type(2))); typedef __bf16 bf16x2_t __attribute__((ext_vector_type(2)));
__device__ __forceinline__ unsigned cvtpk(float lo, float hi) { f32x2_t v = {lo, hi}; bf16x2_t b = __builtin_convertvector(v, bf16x2_t); return __builtin_bit_cast(unsigned, b); }
__device__ __forceinline__ u32x4 pack8(f32x4 a, f32x4 b) { u32x4 w; w.x = cvtpk(a[0], a[1]); w.y = cvtpk(a[2], a[3]); w.z = cvtpk(b[0], b[1]); w.w = cvtpk(b[2], b[3]); return w; }
constexpr float RMS_EPS = 1e-5f;
constexpr float QSCALE = 0.125f * 1.4426950408889634f;
__device__ __forceinline__ float rscale_row(const float* rss, int row, int fq, int lane) {
    const f32x4 v = *(const f32x4*)(rss + (size_t)row * 16 + 4 * fq);
    float s = (v[0] + v[1]) + (v[2] + v[3]);
    s += lx_get(s, lane, 16); s = lx_sum32(s);
    return __builtin_amdgcn_rsqf(s * (1.0f / 1024.0f) + RMS_EPS);
}
struct EpiIn {
    static constexpr bool PERM = true, AFTER_DRAIN = false;
    const float* rss; const float* cosT; const float* sinT; bf16_t* Q; bf16_t* K; bf16_t* V; bf16_t* P;
    __device__ __forceinline__ void operator()(const f32x4 (&acc)[2][2][4][2], const Unit& u, int wr, int wc, int fr, int fq) const {
        const int pn = u.pn, lane = fq * 16 + fr; bf16_t* dst; int ld, colt;
        if (pn < 2) { dst = Q; ld = 512; colt = pn * 256; } else if (pn < 4) { dst = K; ld = 512; colt = (pn - 2) * 256; }
        else if (pn < 6) { dst = V; ld = 512; colt = (pn - 4) * 256; } else { dst = P; ld = 1792; colt = (pn - 6) * 256; }
        const bool qk = pn < 4; const bool rot = qk && ((wc & 1) == 0) && (fq < 2);
        const int col0 = colt + wc * 32 + 8 * fq;
#pragma unroll
        for (int ai = 0; ai < 2; ++ai)
#pragma unroll
            for (int m = 0; m < 4; ++m) {
                const int row = u.pm * BM + ai * HALF + wr * 64 + m * 16 + fr;
                const float rs = rscale_row(rss, row, fq, lane);
                f32x4 c0 = {1.f, 1.f, 1.f, 1.f}, c1 = c0, s0 = {0.f, 0.f, 0.f, 0.f}, s1 = s0;
                if (qk) { c0 = *(const f32x4*)(cosT + (size_t)row * 8); c1 = *(const f32x4*)(cosT + (size_t)row * 8 + 4); s0 = *(const f32x4*)(sinT + (size_t)row * 8); s1 = *(const f32x4*)(sinT + (size_t)row * 8 + 4); }
#pragma unroll
                for (int bj = 0; bj < 2; ++bj) {
                    f32x4 v0 = acc[ai][bj][m][0] * rs, v1 = acc[ai][bj][m][1] * rs;
                    if (qk) {
                        f32x4 p0, p1;
#pragma unroll
                        for (int j = 0; j < 4; ++j) { p0[j] = lx_get(v0[j], lane, 16); p1[j] = lx_get(v1[j], lane, 16); }
                        if (rot) { if (fq == 0) { v0 = v0 * c0 - p0 * s0; v1 = v1 * c1 - p1 * s1; } else { v0 = v0 * c0 + p0 * s0; v1 = v1 * c1 + p1 * s1; } }
                    }
                    if (pn < 2) { v0 = v0 * QSCALE; v1 = v1 * QSCALE; }
                    *(u32x4*)(dst + (size_t)row * ld + col0 + bj * HALF) = pack8(v0, v1);
                }
                asm volatile("" ::: "memory");
            }
    }
};
struct EpiRes {
    static constexpr bool PERM = true, AFTER_DRAIN = false;
    bf16_t* xb; float* rss;
    __device__ __forceinline__ void operator()(const f32x4 (&acc)[2][2][4][2], const Unit& u, int wr, int wc, int fr, int fq) const {
        const int col0 = u.pn * BM + wc * 32 + 8 * fq, lane = fq * 16 + fr;
        u32x4 rb[2][2];
#define RES_LD(gi, buf) do { const size_t off_ = (size_t)(u.pm * BM + ((gi) >> 2) * HALF + wr * 64 + ((gi) & 3) * 16 + fr) * 1024 + col0; \
        rb[buf][0] = *(const u32x4*)(xb + off_); rb[buf][1] = *(const u32x4*)(xb + off_ + HALF); } while (0)
        RES_LD(0, 0);
#pragma unroll
        for (int gi = 0; gi < 8; ++gi) {
            const int ai = gi >> 2, m = gi & 3, buf = gi & 1;
            if (gi < 7) RES_LD(gi + 1, buf ^ 1);
            asm volatile("" ::: "memory");
            const int row = u.pm * BM + ai * HALF + wr * 64 + m * 16 + fr; float ss = 0.f;
#pragma unroll
            for (int bj = 0; bj < 2; ++bj) {
                const u32x4 r = rb[buf][bj];
                const f32x4 b0 = {__uint_as_float(r.x << 16), __uint_as_float(r.x & 0xffff0000u), __uint_as_float(r.y << 16), __uint_as_float(r.y & 0xffff0000u)};
                const f32x4 b1 = {__uint_as_float(r.z << 16), __uint_as_float(r.z & 0xffff0000u), __uint_as_float(r.w << 16), __uint_as_float(r.w & 0xffff0000u)};
                const f32x4 v0 = b0 + acc[ai][bj][m][0], v1 = b1 + acc[ai][bj][m][1];
                ss += (v0[0] * v0[0] + v0[1] * v0[1]) + (v0[2] * v0[2] + v0[3] * v0[3]) + (v1[0] * v1[0] + v1[1] * v1[1]) + (v1[2] * v1[2] + v1[3] * v1[3]);
                *(u32x4*)(xb + (size_t)row * 1024 + col0 + bj * HALF) = pack8(v0, v1);
            }
            ss += lx_get(ss, lane, 16); ss = lx_sum32(ss);
            if (fq == 0) rss[(size_t)row * 16 + 4 * u.pn + wc] = ss;
            asm volatile("" ::: "memory");
        }
#undef RES_LD
    }
};
struct EpiUpConv {
    static constexpr bool PERM = true, AFTER_DRAIN = false;
    const float* rss; const float* cw; const float* cb; bf16_t* A2; PG8_LAS float* wbuf; PG8_LAS float* cbuf;
    __device__ __forceinline__ static float unpk(unsigned w, int hi) { float r; if (hi) asm volatile("v_and_b32 %0, 0xffff0000, %1" : "=v"(r) : "v"(w)); else asm volatile("v_lshlrev_b32 %0, 16, %1" : "=v"(r) : "v"(w)); return r; }
    __device__ __forceinline__ static float unpk2(unsigned w, int hi) { return __builtin_bit_cast(float, hi ? (w & 0xffff0000u) : (w << 16)); }
    __device__ __forceinline__ static void xch8(const unsigned (&w)[8], unsigned csm4, unsigned (&pv)[8], unsigned (&nx)[8]) {
        asm volatile("ds_write_b32 %0, %1 offset:4\n\tds_write_b32 %0, %2 offset:68\n\tds_write_b32 %0, %3 offset:132\n\tds_write_b32 %0, %4 offset:196\n\t"
                     "ds_write_b32 %0, %5 offset:260\n\tds_write_b32 %0, %6 offset:324\n\tds_write_b32 %0, %7 offset:388\n\tds_write_b32 %0, %8 offset:452"
                     :: "v"(csm4), "v"(w[0]), "v"(w[1]), "v"(w[2]), "v"(w[3]), "v"(w[4]), "v"(w[5]), "v"(w[6]), "v"(w[7]));
        asm volatile("ds_read_b32 %0, %16\n\tds_read_b32 %1, %16 offset:64\n\tds_read_b32 %2, %16 offset:128\n\tds_read_b32 %3, %16 offset:192\n\t"
                     "ds_read_b32 %4, %16 offset:256\n\tds_read_b32 %5, %16 offset:320\n\tds_read_b32 %6, %16 offset:384\n\tds_read_b32 %7, %16 offset:448\n\t"
                     "ds_read_b32 %8, %16 offset:8\n\tds_read_b32 %9, %16 offset:72\n\tds_read_b32 %10, %16 offset:136\n\tds_read_b32 %11, %16 offset:200\n\t"
                     "ds_read_b32 %12, %16 offset:264\n\tds_read_b32 %13, %16 offset:328\n\tds_read_b32 %14, %16 offset:392\n\tds_read_b32 %15, %16 offset:456\n\t"
                     "s_waitcnt lgkmcnt(0)"
                     : "=&v"(pv[0]), "=&v"(pv[1]), "=&v"(pv[2]), "=&v"(pv[3]), "=&v"(pv[4]), "=&v"(pv[5]), "=&v"(pv[6]), "=&v"(pv[7]),
                       "=&v"(nx[0]), "=&v"(nx[1]), "=&v"(nx[2]), "=&v"(nx[3]), "=&v"(nx[4]), "=&v"(nx[5]), "=&v"(nx[6]), "=&v"(nx[7])
                     : "v"(csm4));
    }
    __device__ __forceinline__ void operator()(const f32x4 (&acc)[2][2][4][2], const Unit& u, int wr, int wc, int fr, int fq) const {
        const int b = u.pm / 17, it = u.pm % 17, s0 = 252 * it + 126 * wr - 1;
        const int colb = u.pn * 128 + wc * 32 + 8 * fq;
        const int lane = fq * 16 + fr;
        PG8_LAS float* wb = wbuf + (wr * 4 + wc) * 256;
        const unsigned cs = (unsigned)(size_t)(cbuf + (wr * 4 + wc) * 512 + fq * 128 + fr) - 4u;
        { const int gu = lane >> 5, c = lane & 31; const float* src = cw + gu * 2816 + u.pn * 128 + wc * 32 + c;
            const f32x4 t = {src[0], src[5632], src[2 * 5632], cb[gu * 2816 + u.pn * 128 + wc * 32 + c]}; *(PG8_LAS f32x4*)(wb + 4 * lane) = t; }
        float rs[8];
#pragma unroll
        for (int g = 0; g < 8; ++g) { const int s = s0 + 16 * g + fr; const bool ok = (s >= 0) && (s < 4096); const int row = b * 4096 + (ok ? s : 0);
            const float r = rscale_row(rss, row, fq, lane); rs[g] = ok ? r : 0.f; }
#define PIN8(x) asm volatile("" : "+v"(x[0]), "+v"(x[1]), "+v"(x[2]), "+v"(x[3]), "+v"(x[4]), "+v"(x[5]), "+v"(x[6]), "+v"(x[7]))
        unsigned pk[8][2][2][2];
#pragma unroll
        for (int g = 0; g < 8; ++g)
#pragma unroll
            for (int bj = 0; bj < 2; ++bj)
#pragma unroll
                for (int n = 0; n < 2; ++n) { const f32x4 x = acc[g >> 2][bj][g & 3][n] * rs[g]; pk[g][bj][n][0] = cvtpk(x[0], x[1]); pk[g][bj][n][1] = cvtpk(x[2], x[3]); }
#pragma unroll
        for (int n = 0; n < 2; ++n) {
            unsigned res[8][2];
#pragma unroll
            for (int qp = 0; qp < 2; ++qp) {
                float gate[2][8];
                { unsigned w[8], pv[8], nx[8];
#pragma unroll
                    for (int g = 0; g < 8; ++g) w[g] = pk[g][0][n][qp];
                    xch8(w, cs, pv, nx);
#pragma unroll
                    for (int qq = 0; qq < 2; ++qq) { const f32x4 t = *(const PG8_LAS f32x4*)(wb + 4 * (8 * fq + 4 * n + 2 * qp + qq));
                        f32x2_t o[4], e[4];
#pragma unroll
                        for (int gp = 0; gp < 4; ++gp) { const f32x2_t a = {unpk2(w[2 * gp], qq), unpk2(w[2 * gp + 1], qq)}, pp = {unpk2(pv[2 * gp], qq), unpk2(pv[2 * gp + 1], qq)}, xx = {unpk2(nx[2 * gp], qq), unpk2(nx[2 * gp + 1], qq)};
                            o[gp] = ((f32x2_t){t[3], t[3]} + (f32x2_t){t[1], t[1]} * a) + (f32x2_t){t[0], t[0]} * pp + (f32x2_t){t[2], t[2]} * xx; }
#pragma unroll
                        for (int gp = 0; gp < 4; ++gp) { const f32x2_t z = o[gp] * -1.4426950408889634f; e[gp].x = __builtin_amdgcn_exp2f(z.x); e[gp].y = __builtin_amdgcn_exp2f(z.y); }
#pragma unroll
                        for (int gp = 0; gp < 4; ++gp) { const f32x2_t d = e[gp] + 1.0f; f32x2_t r; r.x = __builtin_amdgcn_rcpf(d.x); r.y = __builtin_amdgcn_rcpf(d.y); const f32x2_t gg = o[gp] * r; gate[qq][2 * gp] = gg.x; gate[qq][2 * gp + 1] = gg.y; }
                        PIN8(gate[qq]); } }
                { unsigned w[8], pv[8], nx[8];
#pragma unroll
                    for (int g = 0; g < 8; ++g) w[g] = pk[g][1][n][qp];
                    xch8(w, cs, pv, nx);
#pragma unroll
                    for (int qq = 0; qq < 2; ++qq) { const f32x4 t = *(const PG8_LAS f32x4*)(wb + 4 * (32 + 8 * fq + 4 * n + 2 * qp + qq));
#pragma unroll
                        for (int gp = 0; gp < 4; ++gp) { const f32x2_t a = {unpk2(w[2 * gp], qq), unpk2(w[2 * gp + 1], qq)}, pp = {unpk2(pv[2 * gp], qq), unpk2(pv[2 * gp + 1], qq)}, xx = {unpk2(nx[2 * gp], qq), unpk2(nx[2 * gp + 1], qq)};
                            const f32x2_t o = ((f32x2_t){t[3], t[3]} + (f32x2_t){t[1], t[1]} * a) + (f32x2_t){t[0], t[0]} * pp + (f32x2_t){t[2], t[2]} * xx;
                            const f32x2_t gg = (f32x2_t){gate[qq][2 * gp], gate[qq][2 * gp + 1]} * o; gate[qq][2 * gp] = gg.x; gate[qq][2 * gp + 1] = gg.y; }
                        PIN8(gate[qq]); } }
#pragma unroll
                for (int g = 0; g < 8; ++g) res[g][qp] = cvtpk(gate[0][g], gate[1][g]);
            }
#pragma unroll
            for (int g = 0; g < 8; ++g) { const int j = 16 * g + fr, s = s0 + j;
                if (j >= 1 && j <= 126 && s < 4096) { u32x2 w = {res[g][0], res[g][1]}; *(u32x2*)(A2 + (size_t)(b * 4096 + s) * 2816 + colb + 4 * n) = w; } }
        }
#undef PIN8
        asm volatile("s_waitcnt lgkmcnt(0)" ::: "memory");
    }
};
template <class Epi, class Sched, bool ALIGN_EPI = false, bool SP2 = false, int AMODE = 0>
__device__ __forceinline__ void gemm_phase(PG8_LAS unsigned char* lds, const Gemm g, const Sched& S, const Epi& E, int wave0) {
    unsigned mk_ = ~0u; asm volatile("" : "+s"(mk_)); int tid_raw = (int)__builtin_amdgcn_mbcnt_hi(mk_, __builtin_amdgcn_mbcnt_lo(mk_, 0u)); asm volatile("" : "+v"(tid_raw)); tid_raw += wave0 * 64; const int tid = tid_raw, wid = __builtin_amdgcn_readfirstlane(tid >> 6), lane = tid & 63, wr = wid >> 2, wc = wid & 3, fr = lane & 15, fq = lane >> 4;
    const int K = g.K, nt = K / BK;
    unsigned voffA[2], voffB[2];
#pragma unroll
    for (int i = 0; i < 2; ++i) { int R, C; stage_rc(tid * 16 + i * 8192, R, C); const int Rb = Epi::PERM ? ((R & ~31) + perm32(R & 31)) : R;
        const int Ra = AMODE ? ((R & 63) + 126 * (R >> 6)) : R; voffA[i] = (unsigned)(Ra * K + C) * 2u; voffB[i] = (unsigned)(Rb * K + C) * 2u; }
    const size_t kstep = (size_t)(BK * 2);
    const size_t hstep = (size_t)HALF * K * 2;
    const size_t tstep = 2 * hstep;
    const size_t hstepA = AMODE ? (size_t)64 * K * 2 : hstep;
#define PG8_ABASE(pm_) (AMODE ? (const char*)g.A + ((long)(((pm_) / 17) * 4096 + 252 * ((pm_) % 17) - 1)) * (long)K * 2 : (const char*)g.A + (size_t)(pm_) * tstep)
    const unsigned ldsw = (unsigned)wid * 1024u;
    const int aoff = lds_byte(wr * 64 + fr, fq * 8), boff = lds_byte(wc * 32 + fr, fq * 8);
#define PG8_SA(b, h) (((b) * 2 + (h)) * HTB)
#define PG8_SB(b, h) ((4 + (b) * 2 + (h)) * HTB)
#define PG8_STAGE(bufoff, gbase, voff) do { _Pragma("unroll") for (int _i = 0; _i < 2; ++_i) \
        __builtin_amdgcn_global_load_lds((const unsigned*)((const char*)(gbase) + (voff)[_i]), (PG8_LAS unsigned*)(lds + (bufoff) + ldsw + _i * 8192), 16, 0, 0); } while (0)
#define PG8_LDA(dst, b, h) do { _Pragma("unroll") for (int m = 0; m < 4; ++m) _Pragma("unroll") for (int k = 0; k < 2; ++k) dst[m][k] = *(const PG8_LAS bf16x8*)(lds + PG8_SA(b, h) + aoff + m * 2048 + k * 1024); } while (0)
#define PG8_LDB(dst, b, h) do { _Pragma("unroll") for (int n = 0; n < 2; ++n) _Pragma("unroll") for (int k = 0; k < 2; ++k) dst[n][k] = *(const PG8_LAS bf16x8*)(lds + PG8_SB(b, h) + boff + n * 2048 + k * 1024); } while (0)
#define PG8_MMA(ai, bj, At, Bt) do { __builtin_amdgcn_s_setprio(1); _Pragma("unroll") for (int m = 0; m < 4; ++m) _Pragma("unroll") for (int n = 0; n < 2; ++n) _Pragma("unroll") for (int k = 0; k < 2; ++k) \
        acc[ai][bj][m][n] = __builtin_amdgcn_mfma_f32_16x16x32_bf16(Bt[n][k], At[m][k], acc[ai][bj][m][n], 0, 0, 0); __builtin_amdgcn_s_setprio(0); } while (0)
#define PG8_WAIT_V(n) asm volatile("s_waitcnt vmcnt(" #n ")" ::: "memory")
#define PG8_WAIT_L(n) asm volatile("s_waitcnt lgkmcnt(" #n ")" ::: "memory")
#define PG8_BAR __builtin_amdgcn_s_barrier()
#define PG8_SCHED __builtin_amdgcn_sched_barrier(0)
    Unit cur, nxt; int ui = 0;
    if (!S.next(0, cur)) return;
    f32x4 acc[2][2][4][2];
#pragma unroll
    for (int a = 0; a < 2; ++a)
#pragma unroll
        for (int b = 0; b < 2; ++b)
#pragma unroll
            for (int m = 0; m < 4; ++m)
#pragma unroll
                for (int n = 0; n < 2; ++n) acc[a][b][m][n] = (f32x4){0.f, 0.f, 0.f, 0.f};
    bf16x8 At[4][2], B0[2][2], B1[2][2];
    const char* cA = PG8_ABASE(cur.pm); const char* cB = (const char*)g.Bt + (size_t)cur.pn * tstep;
    S.a_ready(cur);
    if constexpr (SP2) {
        PG8_STAGE(PG8_SB(0, 0), cB, voffB); PG8_STAGE(PG8_SB(0, 1), cB + hstep, voffB); PG8_STAGE(PG8_SA(0, 0), cA, voffA); PG8_STAGE(PG8_SA(0, 1), cA + hstepA, voffA);
        if (wr == 1) PG8_BAR;
        PG8_WAIT_V(2); PG8_BAR;
        PG8_STAGE(PG8_SB(1, 0), cB + kstep, voffB); PG8_STAGE(PG8_SA(1, 0), cA + kstep, voffA); PG8_STAGE(PG8_SB(1, 1), cB + hstep + kstep, voffB);
        PG8_WAIT_V(6); PG8_BAR;
    } else {
        PG8_STAGE(PG8_SB(0, 0), cB, voffB); PG8_STAGE(PG8_SA(0, 0), cA, voffA); PG8_STAGE(PG8_SB(0, 1), cB + hstep, voffB); PG8_STAGE(PG8_SA(0, 1), cA + hstepA, voffA);
        if (wr == 1) PG8_BAR;
        PG8_WAIT_V(4); PG8_BAR;
        PG8_STAGE(PG8_SB(1, 0), cB + kstep, voffB); PG8_STAGE(PG8_SA(1, 0), cA + kstep, voffA); PG8_STAGE(PG8_SB(1, 1), cB + hstep + kstep, voffB);
        PG8_WAIT_V(6); PG8_BAR;
    }
    for (;;) {
        const bool has_next = S.next(ui + 1, nxt);
        const char* nA = has_next ? PG8_ABASE(nxt.pm) : cA; const char* nB = has_next ? (const char*)g.Bt + (size_t)nxt.pn * tstep : cB;
        for (int t = 0; t < nt; t += 2) {
            const bool last = (t == nt - 2);
            const char* a1 = cA + (size_t)(t + 1) * kstep;
            const char* a2 = last ? nA : cA + (size_t)(t + 2) * kstep; const char* b2 = last ? nB : cB + (size_t)(t + 2) * kstep;
            const char* a3 = a2 + kstep; const char* b3 = b2 + kstep;
            if (last && has_next) S.a_ready(nxt);
            if constexpr (SP2) {
            PG8_LDB(B0, 0, 0); PG8_LDB(B1, 0, 1); PG8_SCHED; PG8_LDA(At, 0, 0); PG8_STAGE(PG8_SA(1, 1), a1 + hstepA, voffA);
            PG8_WAIT_V(8); PG8_WAIT_L(0); PG8_BAR; PG8_MMA(0, 0, At, B0); PG8_MMA(0, 1, At, B1); PG8_BAR; PG8_SCHED;
            PG8_LDA(At, 0, 1); PG8_STAGE(PG8_SB(0, 0), b2, voffB); PG8_STAGE(PG8_SB(0, 1), b2 + hstep, voffB); PG8_STAGE(PG8_SA(0, 0), a2, voffA);
            PG8_WAIT_V(8); PG8_WAIT_L(0); PG8_BAR; PG8_MMA(1, 0, At, B0); PG8_MMA(1, 1, At, B1); PG8_BAR; PG8_SCHED;
            PG8_LDB(B0, 1, 0); PG8_LDB(B1, 1, 1); PG8_SCHED; PG8_LDA(At, 1, 0); PG8_STAGE(PG8_SA(0, 1), a2 + hstepA, voffA);
            PG8_WAIT_V(8); PG8_WAIT_L(0); PG8_BAR; PG8_MMA(0, 0, At, B0); PG8_MMA(0, 1, At, B1); PG8_BAR; PG8_SCHED;
            PG8_LDA(At, 1, 1); PG8_STAGE(PG8_SB(1, 0), b3, voffB); PG8_STAGE(PG8_SB(1, 1), b3 + hstep, voffB); PG8_STAGE(PG8_SA(1, 0), a3, voffA);
            PG8_WAIT_V(8); PG8_WAIT_L(0); PG8_BAR; PG8_MMA(1, 0, At, B0); PG8_MMA(1, 1, At, B1); PG8_BAR; PG8_SCHED;
            } else {
            PG8_LDB(B0, 0, 0); PG8_SCHED; PG8_LDA(At, 0, 0); PG8_STAGE(PG8_SA(1, 1), a1 + hstepA, voffA);
            PG8_WAIT_L(8); PG8_BAR; PG8_WAIT_L(0); PG8_MMA(0, 0, At, B0); PG8_BAR; PG8_SCHED;
            PG8_LDB(B1, 0, 1); PG8_STAGE(PG8_SB(0, 0), b2, voffB);
            PG8_BAR; PG8_WAIT_L(0); PG8_MMA(0, 1, At, B1); PG8_BAR;
            PG8_LDA(At, 0, 1); PG8_STAGE(PG8_SA(0, 0), a2, voffA);
            PG8_BAR; PG8_WAIT_L(0); PG8_MMA(1, 0, At, B0); PG8_BAR; PG8_SCHED;
            PG8_STAGE(PG8_SB(0, 1), b2 + hstep, voffB);
            PG8_WAIT_V(6); PG8_BAR; PG8_MMA(1, 1, At, B1); PG8_BAR;
            PG8_LDB(B0, 1, 0); PG8_SCHED; PG8_LDA(At, 1, 0); PG8_STAGE(PG8_SA(0, 1), a2 + hstepA, voffA);
            PG8_WAIT_L(8); PG8_BAR; PG8_WAIT_L(0); PG8_MMA(0, 0, At, B0); PG8_BAR; PG8_SCHED;
            PG8_LDB(B1, 1, 1); PG8_STAGE(PG8_SB(1, 0), b3, voffB);
            PG8_BAR; PG8_WAIT_L(0); PG8_MMA(0, 1, At, B1); PG8_BAR;
            PG8_LDA(At, 1, 1); PG8_STAGE(PG8_SA(1, 0), a3, voffA);
            PG8_BAR; PG8_WAIT_L(0); PG8_MMA(1, 0, At, B0); PG8_BAR; PG8_SCHED;
            PG8_STAGE(PG8_SB(1, 1), b3 + hstep, voffB);
            PG8_WAIT_V(6); PG8_BAR; PG8_MMA(1, 1, At, B1); PG8_BAR;
            }
        }
        if constexpr (ALIGN_EPI) { if (wr == 0) PG8_BAR; }
        if constexpr (!Epi::AFTER_DRAIN) { E(acc, cur, wr, wc, fr, fq); S.done(cur); }
        if (!has_next) break;
#pragma unroll
        for (int a = 0; a < 2; ++a)
#pragma unroll
            for (int b = 0; b < 2; ++b)
#pragma unroll
                for (int m = 0; m < 4; ++m)
#pragma unroll
                    for (int n = 0; n < 2; ++n) acc[a][b][m][n] = (f32x4){0.f, 0.f, 0.f, 0.f};
        cur = nxt; cA = nA; cB = nB; ++ui;
        if constexpr (ALIGN_EPI) { if (wr == 1) PG8_BAR; }
    }
    PG8_WAIT_V(0);
    if constexpr (!ALIGN_EPI) { if (wr == 0) PG8_BAR; }
    PG8_BAR;
    if constexpr (Epi::AFTER_DRAIN) { E.fused(acc, cur, wr, wc, fr, fq, lds, wid, lane); S.done(cur); }
#undef PG8_SA
#undef PG8_ABASE
#undef PG8_SB
#undef PG8_STAGE
#undef PG8_LDA
#undef PG8_LDB
#undef PG8_MMA
#undef PG8_WAIT_V
#undef PG8_WAIT_L
#undef PG8_BAR
#undef PG8_SCHED
}
}
namespace attn {
using bf16x8 = __attribute__((ext_vector_type(8))) short;
using s16x4  = __attribute__((ext_vector_type(4))) short;
using f32x16 = __attribute__((ext_vector_type(16))) float;
using f32x4  = __attribute__((ext_vector_type(4))) float;
using u32x4  = __attribute__((ext_vector_type(4))) unsigned;
typedef unsigned short bf16_t;
constexpr int NW = 8, QBLK = 32, KVBLK = 64, LDQ = 512, LDK = 512, SEQ = 4096, LDY = 1024;
#define SBAR() __builtin_amdgcn_sched_barrier(0)
__device__ __forceinline__ int crow(int r, int hi) { return (r & 3) + 8 * (r >> 2) + 4 * hi; }
typedef float f32x2_t __attribute__((ext_vector_type(2))); typedef __bf16 bf16x2_t __attribute__((ext_vector_type(2)));
__device__ __forceinline__ unsigned cvtpk(float lo, float hi) { f32x2_t v = {lo, hi}; bf16x2_t b = __builtin_convertvector(v, bf16x2_t); return __builtin_bit_cast(unsigned, b); }

__device__ __forceinline__ int v_rd_base(int lane) { return ((lane & 3) << 3) | (((lane >> 2) & 3) << 6) | (((lane >> 4) & 1) << 5) | (((lane >> 5) & 1) << 8); }
constexpr int v_rd_off(int d0, int ks, int half) { return d0 * 512 + ks * 4096 + half * 2048; }
template <int OFF> __device__ __forceinline__ s16x4 tr_read(int vb) {
  s16x4 r; asm volatile("ds_read_b64_tr_b16 %0, %1 offset:%2" : "=&v"(r) : "v"(vb), "i"(OFF) : "memory"); return r;
}
constexpr int A2_K = 0, A2_V = 32768, A2_Q = 81920, A2_WS = 147456, A2_OB = 0;
typedef __attribute__((address_space(3))) char lchar;
typedef __attribute__((address_space(3))) unsigned luint;
#define GLDS16(gp, lp) __builtin_amdgcn_global_load_lds((const unsigned*)(gp), (luint*)(lp), 16, 0, 0)
__device__ __forceinline__ void glds16_so(const void* sbase, unsigned voff, unsigned lds_dst) {
  unsigned keep; asm volatile("s_nop 4\n\ts_mov_b32 %0, m0\n\ts_mov_b32 m0, %3\n\ts_nop 0\n\tglobal_load_lds_dwordx4 %1, %2\n\ts_mov_b32 m0, %0" : "=&s"(keep) : "v"(voff), "s"(sbase), "s"(lds_dst) : "memory"); }
template <int D0> __device__ __forceinline__ void pv2_one(f32x16& oa, f32x16& ob, int vb, const bf16x8 (&pa)[4], const bf16x8 (&pb)[4]) {
#define PK(L, H) (bf16x8){L[0], L[1], L[2], L[3], H[0], H[1], H[2], H[3]}
  { const s16x4 l0 = tr_read<v_rd_off(D0, 0, 0)>(vb), h0 = tr_read<v_rd_off(D0, 0, 1)>(vb), l1 = tr_read<v_rd_off(D0, 1, 0)>(vb), h1 = tr_read<v_rd_off(D0, 1, 1)>(vb);
    asm volatile("s_waitcnt lgkmcnt(0)" ::: "memory"); SBAR();
    const bf16x8 v0 = PK(l0, h0), v1 = PK(l1, h1);
    __builtin_amdgcn_s_setprio(1);
    oa = __builtin_amdgcn_mfma_f32_32x32x16_bf16(pa[0], v0, oa, 0, 0, 0); ob = __builtin_amdgcn_mfma_f32_32x32x16_bf16(pb[0], v0, ob, 0, 0, 0);
    oa = __builtin_amdgcn_mfma_f32_32x32x16_bf16(pa[1], v1, oa, 0, 0, 0); ob = __builtin_amdgcn_mfma_f32_32x32x16_bf16(pb[1], v1, ob, 0, 0, 0); __builtin_amdgcn_s_setprio(0); }
  { const s16x4 l2 = tr_read<v_rd_off(D0, 2, 0)>(vb), h2 = tr_read<v_rd_off(D0, 2, 1)>(vb), l3 = tr_read<v_rd_off(D0, 3, 0)>(vb), h3 = tr_read<v_rd_off(D0, 3, 1)>(vb);
    asm volatile("s_waitcnt lgkmcnt(0)" ::: "memory"); SBAR();
    const bf16x8 v2 = PK(l2, h2), v3 = PK(l3, h3);
    __builtin_amdgcn_s_setprio(1);
    oa = __builtin_amdgcn_mfma_f32_32x32x16_bf16(pa[2], v2, oa, 0, 0, 0); ob = __builtin_amdgcn_mfma_f32_32x32x16_bf16(pb[2], v2, ob, 0, 0, 0);
    oa = __builtin_amdgcn_mfma_f32_32x32x16_bf16(pa[3], v3, oa, 0, 0, 0); ob = __builtin_amdgcn_mfma_f32_32x32x16_bf16(pb[3], v3, ob, 0, 0, 0); __builtin_amdgcn_s_setprio(0); }
#undef PK
}
__device__ __forceinline__ void pv2(f32x16 (&oa)[4], f32x16 (&ob)[4], int vb, const bf16x8 (&pa)[4], const bf16x8 (&pb)[4]) {
  pv2_one<0>(oa[0], ob[0], vb, pa, pb); pv2_one<1>(oa[1], ob[1], vb, pa, pb); pv2_one<2>(oa[2], ob[2], vb, pa, pb); pv2_one<3>(oa[3], ob[3], vb, pa, pb);
}
template <int D0A, int D0B> __device__ __forceinline__ void qk_load(const lchar* Ks, int koff, int comp, bf16x8 (&k0)[4], bf16x8 (&k1)[4]) {
  typedef __attribute__((address_space(3))) bf16x8 lfrag;
#pragma unroll
  for (int d0 = D0A; d0 < D0B; ++d0) { const int off = (koff & ~0xF0) | ((koff ^ ((comp * 8 + d0 * 2) << 4)) & 0xF0);
    k0[d0] = *(const lfrag*)(Ks + off); k1[d0] = *(const lfrag*)(Ks + off + 8192); }
}
__device__ __forceinline__ void qk_mma(const bf16x8 (&q)[4], const bf16x8 (&k0)[4], const bf16x8 (&k1)[4], f32x16& p0, f32x16& p1) {
  p0 = __builtin_amdgcn_mfma_f32_32x32x16_bf16(k0[0], q[0], f32x16{}, 0, 0, 0); p1 = __builtin_amdgcn_mfma_f32_32x32x16_bf16(k1[0], q[0], f32x16{}, 0, 0, 0);
#pragma unroll
  for (int d0 = 1; d0 < 4; ++d0) { p0 = __builtin_amdgcn_mfma_f32_32x32x16_bf16(k0[d0], q[d0], p0, 0, 0, 0); p1 = __builtin_amdgcn_mfma_f32_32x32x16_bf16(k1[d0], q[d0], p1, 0, 0, 0); }
}
__device__ __forceinline__ void sm_part(f32x16& p0, f32x16& p1, float mref, bool use_ref, float& l_reg, bf16x8 (&pa)[4]) {
#define PK4(P, BASE, OUT) do { u32x4 w = {cvtpk(P[BASE + 0], P[BASE + 1]), cvtpk(P[BASE + 2], P[BASE + 3]), cvtpk(P[BASE + 4], P[BASE + 5]), cvtpk(P[BASE + 6], P[BASE + 7])}; \
    OUT = *reinterpret_cast<bf16x8*>(&w); } while (0)
  if (use_ref) {
    float m_ = mref; asm volatile("" : "+v"(m_));
#pragma unroll
    for (int r = 0; r < 16; ++r) { p0[r] -= m_; p1[r] -= m_; } }
  { float ps[4] = {0.f, 0.f, 0.f, 0.f};
#pragma unroll
    for (int r = 0; r < 16; ++r) { p0[r] = __builtin_amdgcn_exp2f(p0[r]); ps[r & 3] += p0[r]; }
    l_reg += (ps[0] + ps[1]) + (ps[2] + ps[3]); asm volatile("" : "+v"(l_reg));
    PK4(p0, 0, pa[0]); PK4(p0, 8, pa[1]); }
  { float ps[4] = {0.f, 0.f, 0.f, 0.f};
#pragma unroll
    for (int r = 0; r < 16; ++r) { p1[r] = __builtin_amdgcn_exp2f(p1[r]); ps[r & 3] += p1[r]; }
    l_reg += (ps[0] + ps[1]) + (ps[2] + ps[3]); asm volatile("" : "+v"(l_reg));
    PK4(p1, 0, pa[2]); PK4(p1, 8, pa[3]); }
#undef PK4
  asm volatile("" : "+v"(pa[0]), "+v"(pa[1]), "+v"(pa[2]), "+v"(pa[3]));
}
__device__ __forceinline__ void attn_unit2(const bf16_t* __restrict__ Qg, const bf16_t* __restrict__ Kg, const bf16_t* __restrict__ Vg, bf16_t* __restrict__ Yg,
                                           int b, int h, int q0, float lam, float lam_init, const float* __restrict__ subg, const unsigned* __restrict__ kmax2, lchar* lds, int wave0) {
  unsigned mk_ = ~0u; asm volatile("" : "+s"(mk_)); int tid_raw = (int)__builtin_amdgcn_mbcnt_hi(mk_, __builtin_amdgcn_mbcnt_lo(mk_, 0u)); asm volatile("" : "+v"(tid_raw)); tid_raw += wave0 * 64; const int tid = tid_raw, wid = __builtin_amdgcn_readfirstlane(tid >> 6), lane = tid & 63, r32 = lane & 31, hi = lane >> 5;
  const bool grpB = wid >= 4;
  const long rowbase = (long)b * SEQ;
  const bf16_t* Kh = Kg + rowbase * LDK + h * 128; const bf16_t* Vh = Vg + rowbase * LDK + h * 128;
  unsigned koffs[2], voffs[2];
#pragma unroll
  for (int ii = 0; ii < 2; ++ii) { const int s = 64 * (2 * wid + ii) + lane; const int row = s >> 4, ch = (s & 15) ^ (row & 15); koffs[ii] = (unsigned)(row * LDK + ch * 8) * 2u;
    const int st = s >> 5, kk = (st >> 2) * 8 + ((s >> 2) & 7), k = kk  , c8 = (st & 3) * 4 + (s & 3); voffs[ii] = (unsigned)(k * LDK + c8 * 8) * 2u; }
  lchar* Qw = lds + A2_Q + wid * 8192; const unsigned ldsb = (unsigned)(size_t)lds;
  { const bf16_t* Qrow = Qg + (rowbase + q0 + wid * QBLK) * LDQ + h * 128;
#pragma unroll
    for (int i = 0; i < 8; ++i) { const int s = 64 * i + lane, row = s >> 4, ch = (s & 15) ^ (row & 15); GLDS16(Qrow + row * LDQ + ch * 8, Qw + i * 1024); } }
#define DMA_KV(t, sk, sv) do { const char* kt_ = (const char*)(Kh + (long)(t) * KVBLK * LDK); const char* vt_ = (const char*)(Vh + (long)(t) * KVBLK * LDK); \
    _Pragma("unroll") for (int ii = 0; ii < 2; ++ii) { glds16_so(kt_, koffs[ii], ldsb + A2_K + (sk) * 16384 + (2 * wid + ii) * 1024); \
    glds16_so(vt_, voffs[ii], ldsb + A2_V + (sv) * 16384 + (2 * wid + ii) * 1024); } } while (0)
  DMA_KV(0, 0, 0);
  const int koff = r32 * 256 + (((hi) ^ (r32 & 15)) << 4);
  const int vb0 = (int)(size_t)(lds + A2_V) + v_rd_base(lane);
  float l1 = 0.f, l2 = 0.f, mref1, mref2; f32x16 o1[4] = {}, o2[4] = {}; bf16x8 pa1[4], pa2[4];
  asm volatile("s_waitcnt vmcnt(0)" ::: "memory");
  bf16x8 qf1[4], qf2[4];
  { float qa = 0.f, qb = 0.f;
#pragma unroll
    for (int d0 = 0; d0 < 4; ++d0) { const int off = (koff & ~0xF0) | ((koff ^ ((d0 * 2) << 4)) & 0xF0);
      const bf16x8 x = *(const __attribute__((address_space(3))) bf16x8*)(Qw + off), y = *(const __attribute__((address_space(3))) bf16x8*)(Qw + (off ^ 0x80)); qf1[d0] = x; qf2[d0] = y;
#pragma unroll
      for (int j = 0; j < 8; ++j) { const float fx = __uint_as_float((unsigned)(unsigned short)x[j] << 16), fy = __uint_as_float((unsigned)(unsigned short)y[j] << 16); qa += fx * fx; qb += fy * fy; } }
    qa = lx_sum32(qa);
    qb = lx_sum32(qb);
    const float ka = __uint_as_float(kmax2[(b * 4 + h) * 2 + 0]), kb = __uint_as_float(kmax2[(b * 4 + h) * 2 + 1]);
    mref1 = fmaxf(__builtin_amdgcn_sqrtf(qa * ka) * 1.001f - 64.f, 0.f); mref2 = fmaxf(__builtin_amdgcn_sqrtf(qb * kb) * 1.001f - 64.f, 0.f); }
  const bool use_ref = __any((mref1 != 0.f) || (mref2 != 0.f));
  const int NT = SEQ / KVBLK; int sk = 0, sv = 0, svp = 0;
  for (int j = 0; j < NT; ++j) {
    asm volatile("s_waitcnt vmcnt(0) lgkmcnt(0)\n\ts_barrier" ::: "memory");
    const int skn = sk ^ 1, svn = (sv == 2) ? 0 : sv + 1;
    if (j + 1 < NT) DMA_KV(j + 1, skn, svn);
    { bf16x8 kA0[4], kA1[4], kB0[4], kB1[4]; f32x16 sa0, sa1, sb0, sb1;
      if (grpB && j > 0) pv2(o1, o2, vb0 + svp * 16384, pa1, pa2);
      qk_load<0, 4>(lds + A2_K + sk * 16384, koff, 0, kA0, kA1); SBAR();
      qk_mma(qf1, kA0, kA1, sa0, sa1);
      qk_load<0, 2>(lds + A2_K + sk * 16384, koff, 1, kB0, kB1); SBAR();
      sm_part(sa0, sa1, mref1, use_ref, l1, pa1);
      SBAR();
      qk_load<2, 4>(lds + A2_K + sk * 16384, koff, 1, kB0, kB1);
      qk_mma(qf2, kB0, kB1, sb0, sb1);
      __builtin_amdgcn_sched_group_barrier(0x8, 2, 0); __builtin_amdgcn_sched_group_barrier(0x100, 2, 0); __builtin_amdgcn_sched_group_barrier(0x8, 2, 0); __builtin_amdgcn_sched_group_barrier(0x100, 2, 0);
      __builtin_amdgcn_sched_group_barrier(0x8, 4, 0); SBAR();
      sm_part(sb0, sb1, mref2, use_ref, l2, pa2); }
    if (!grpB) pv2(o1, o2, vb0 + sv * 16384, pa1, pa2);
    svp = sv; sk = skn; sv = svn;
  }
  if (grpB) pv2(o1, o2, vb0 + svp * 16384, pa1, pa2);
#undef DMA_KV
  unsigned mk2_ = ~0u; asm volatile("" : "+s"(mk2_)); int lane_e = (int)__builtin_amdgcn_mbcnt_hi(mk2_, __builtin_amdgcn_mbcnt_lo(mk2_, 0u)); asm volatile("" : "+v"(lane_e));
  l1 = lx_sum32(l1);
  l2 = lx_sum32(l2);
  __attribute__((address_space(3))) float* wsf = (__attribute__((address_space(3))) float*)(lds + A2_WS) + wid * 64;
  const int r32e = lane_e & 31, hie = lane_e >> 5;
  const float* subg_e = subg; asm volatile("" : "+s"(subg_e));
  if (hie == 0) { wsf[r32e] = __builtin_amdgcn_rcpf(l1); wsf[32 + r32e] = lam * __builtin_amdgcn_rcpf(l2); }
  asm volatile("s_waitcnt vmcnt(0) lgkmcnt(0)\n\ts_barrier" ::: "memory");
  __attribute__((address_space(3))) float* OB = (__attribute__((address_space(3))) float*)(lds + A2_OB + wid * 16384);
#pragma unroll
  for (int r = 0; r < 16; ++r) { const int orow = crow(r, hie); const float ra = wsf[orow], rb = wsf[32 + orow];
#pragma unroll
    for (int d0 = 0; d0 < 4; ++d0) { const int col = d0 * 32 + r32e; OB[orow * 128 + ((((col >> 2) ^ (orow & 7)) << 2) | (col & 3))] = o1[d0][r] * ra - o2[d0][r] * rb; } }
  asm volatile("s_waitcnt lgkmcnt(0)" ::: "memory");
  { const int row = lane_e >> 1, half = lane_e & 1; float ss = 0.f;
#pragma unroll
    for (int i = 0; i < 16; ++i) { const f32x4 v = *(const __attribute__((address_space(3))) f32x4*)(OB + row * 128 + (((16 * half + i) ^ (row & 7)) << 2)); ss += (v[0] * v[0] + v[1] * v[1]) + (v[2] * v[2] + v[3] * v[3]); }
    ss += __builtin_bit_cast(float, __builtin_amdgcn_update_dpp(0, __builtin_bit_cast(int, ss), 0xB1, 0xf, 0xf, false));
    float li_ = lam_init; asm volatile("" : "+s"(li_));
    const float rstd = (1.0f - li_) * __builtin_amdgcn_rsqf(ss * (1.0f / 128.0f) + 1e-5f);
    bf16_t* yp = Yg + (rowbase + q0 + wid * QBLK + row) * LDY + h * 128 + half * 64;
#pragma unroll 2
    for (int i = 0; i < 8; ++i) { const f32x4 g0 = *(const f32x4*)(subg_e + half * 64 + 8 * i), g1 = *(const f32x4*)(subg_e + half * 64 + 8 * i + 4);
      const f32x4 va = *(const __attribute__((address_space(3))) f32x4*)(OB + row * 128 + (((16 * half + 2 * i) ^ (row & 7)) << 2)), vc = *(const __attribute__((address_space(3))) f32x4*)(OB + row * 128 + (((16 * half + 2 * i + 1) ^ (row & 7)) << 2));
      const f32x4 a = va * g0 * rstd, c = vc * g1 * rstd;
      u32x4 w = {cvtpk(a[0], a[1]), cvtpk(a[2], a[3]), cvtpk(c[0], c[1]), cvtpk(c[2], c[3])};
      *(u32x4*)(yp + 8 * i) = w; } }
  asm volatile("s_waitcnt vmcnt(0) lgkmcnt(0)\n\ts_barrier" ::: "memory");
}
#undef GLDS16
#undef SBAR
}
#define LAS __attribute__((address_space(3)))
#define XB_TMO      128
#define XB_XCNT(j)  (256  + 64 * (j))
#define XB_XSUB(j)  (1280 + 64 * (j))
#define XB_XGEN(j)  (2304 + 64 * (j))
#define XB_TOP      3328
#define XB_TOPGEN   3392
#define XCD_BAR_WORDS 3456
#define XB_SPIN_CAP (1u << 18)

__device__ __forceinline__ unsigned xb_ld(unsigned* p)              { asm volatile("" : "+v"(p)); return __hip_atomic_load(p, __ATOMIC_RELAXED, __HIP_MEMORY_SCOPE_AGENT); }
__device__ __forceinline__ unsigned xb_add(unsigned* p, unsigned v) { asm volatile("" : "+v"(p), "+v"(v)); return __hip_atomic_fetch_add(p, v, __ATOMIC_RELAXED, __HIP_MEMORY_SCOPE_AGENT); }
__device__ __forceinline__ unsigned xb_xcc_id() { return (unsigned)__builtin_amdgcn_s_getreg((3 << 11) | 20) & 0xFu; }
#define XB_SPIN(cond, bar) do { unsigned _sp = 0; while (cond) { __builtin_amdgcn_s_sleep(1); \
    if ((++_sp & 255u) == 0u) { if (xb_ld(&(bar)[XB_TMO])) break; if (_sp > XB_SPIN_CAP) { atomicAdd(&(bar)[XB_TMO], 1u); break; } } } } while (0)

__device__ __forceinline__ bool xb_lane0() { unsigned mk_ = ~0u; asm volatile("" : "+s"(mk_)); return __builtin_amdgcn_mbcnt_hi(mk_, __builtin_amdgcn_mbcnt_lo(mk_, 0u)) == 0u; }
struct XcdBarrier {
    int w0;
    unsigned* bar; unsigned x;
    volatile LAS unsigned* st;
};

__device__ __forceinline__ XcdBarrier xcd_barrier_post(unsigned* bar, volatile LAS unsigned* st, int w0) {
    XcdBarrier b; b.w0 = w0; b.bar = bar; b.x = xb_xcc_id(); b.st = st;
    if (b.w0 == 0 && xb_lane0()) (void)xb_add(&bar[XB_XCNT(b.x)], 1u);
    return b;
}
__device__ __forceinline__ void xcd_barrier_complete(unsigned* bar, unsigned x, unsigned& nloc, unsigned& nx) {
    const unsigned G = gridDim.x * gridDim.y * gridDim.z;
    unsigned sum, cnt, mine, sp = 0u;
    for (;;) {
        sum = 0u; cnt = 0u; mine = 0u;
#pragma unroll
        for (unsigned j = 0; j < 16; ++j) { const unsigned c = xb_ld(&bar[XB_XCNT(j)]); sum += c; cnt += (c > 0u) ? 1u : 0u; mine = (j == x) ? c : mine; }
        if (sum == G) break;
        __builtin_amdgcn_s_sleep(1);
        if ((++sp & 255u) == 0u) { if (xb_ld(&bar[XB_TMO])) break; if (sp > XB_SPIN_CAP) { atomicAdd(&bar[XB_TMO], 1u); break; } }
    }
    nloc = mine > 0u ? mine : 1u; nx = cnt > 0u ? cnt : 1u;
}

__device__ __forceinline__ void xcd_barrier(const XcdBarrier& b) {
    asm volatile("s_waitcnt vmcnt(0)" ::: "memory");
    __syncthreads();
    if (b.w0 == 0 && xb_lane0()) {
        unsigned* bar = b.bar;
        __builtin_amdgcn_s_waitcnt(0);
        unsigned nloc = b.st[0], nx = b.st[1];
        if (nloc == 0u) { xcd_barrier_complete(bar, b.x, nloc, nx); b.st[0] = nloc; b.st[1] = nx; }
        const unsigned old = xb_add(&bar[XB_XSUB(b.x)], 1u);
        const unsigned gen = old / nloc;
        if (old + 1u == (gen + 1u) * nloc) {
            __builtin_amdgcn_fence(__ATOMIC_RELEASE, "agent");
            asm volatile("s_waitcnt vmcnt(0)" ::: "memory");
            const unsigned og = xb_add(&bar[XB_TOP], 1u);
            const unsigned tg = og / nx;
            if (og + 1u == (tg + 1u) * nx) xb_add(&bar[XB_TOPGEN], 1u);
            else XB_SPIN(xb_ld(&bar[XB_TOPGEN]) == tg, bar);
            __builtin_amdgcn_fence(__ATOMIC_ACQUIRE, "agent");
            xb_add(&bar[XB_XGEN(b.x)], 1u);
            asm volatile("s_waitcnt vmcnt(0)" ::: "memory");
        } else {
            XB_SPIN(xb_ld(&bar[XB_XGEN(b.x)]) == gen, bar);
            __builtin_amdgcn_fence(__ATOMIC_ACQUIRE, "agent");
            asm volatile("s_waitcnt vmcnt(0)" ::: "memory");
        }
    }
    __syncthreads();
}
#undef LAS
#define LAS __attribute__((address_space(3)))
typedef unsigned short bf16;
typedef float f32x4 __attribute__((ext_vector_type(4)));
typedef float f32x16 __attribute__((ext_vector_type(16)));
typedef short bf16x8 __attribute__((ext_vector_type(8)));
typedef short s16x4 __attribute__((ext_vector_type(4)));
typedef unsigned u32x4 __attribute__((ext_vector_type(4)));
typedef unsigned u32x2 __attribute__((ext_vector_type(2)));
typedef short v4i16_t __attribute__((ext_vector_type(4)));

constexpr int NWAVES = 8, NTHREADS = 512;
constexpr int BATCH = 4, SEQ = 4096, D = 1024, DEPTH = 4, M = BATCH * SEQ;
constexpr int IN_COLS = 3336, IN_MAIN = 3328, DFF = 2816, UPW = 5632;
constexpr float LOG2E = 1.4426950408889634f;
constexpr int LDS_BYTES = 163840, LDSCTL_OFF = LDS_BYTES - 512;

constexpr size_t MiB = 1u << 20;
constexpr size_t WS_CTL = 0, CTL_ZERO_BYTES = 64 * 1024;
constexpr size_t WS_COS = 1 * MiB, WS_SIN = WS_COS + 512 * 1024, WS_RSS = 2 * MiB, WS_DT = 3 * MiB, WS_CD = WS_DT + 512 * 1024, WS_KMAX = WS_CD + 65536, WS_SSDV = 4 * MiB;
constexpr size_t WS_W0 = 8 * MiB, W_LAYER = 25 * MiB, WO_IN = 0, WO_OUT = 6815744, WO_UP = WO_OUT + 2 * MiB, WO_DOWN = WO_UP + 11 * MiB;
constexpr size_t WS_XG = 108 * MiB;
constexpr size_t WS_Q = 140 * MiB, WS_K = 156 * MiB, WS_V = 172 * MiB, WS_P = 188 * MiB, WS_XBC = 244 * MiB, WS_Y = 268 * MiB, WS_S = 300 * MiB;
constexpr size_t WS_A2 = 140 * MiB;
constexpr size_t WS_END = 332 * MiB;
static_assert(WO_DOWN + (size_t)D * DFF * 2 <= W_LAYER && WS_W0 + DEPTH * W_LAYER <= WS_XG && WS_A2 + (size_t)M * DFF * 2 <= WS_XBC && WS_S + (size_t)BATCH * 32 * 4 * 2 * 8192 * 4 <= WS_END, "ws map");
constexpr int CW_BAR = 1024;
constexpr int CW_SCAN = 8192;

struct Params { const float* in[23]; float* out; unsigned char* ws; int ph_lo, ph_hi; };
enum { I_X = 0, I_POS, I_NMG, I_WIN, I_LQ1, I_LK1, I_LQ2, I_LK2, I_SUBG, I_SCW, I_SSDW, I_SSDB, I_DTB, I_ALOG, I_SSDD, I_SSDNG, I_WOUT, I_NFG, I_WUP, I_FCW, I_FCB, I_WDOWN, I_FNG };

__device__ __forceinline__ float bf2f(unsigned short h) { return __uint_as_float((unsigned)h << 16); }
__device__ __forceinline__ float bflo(unsigned w) { return __uint_as_float(w << 16); }
__device__ __forceinline__ float bfhi(unsigned w) { return __uint_as_float(w & 0xffff0000u); }
__device__ __forceinline__ void unpack8(u32x4 w, float* f) { f[0] = bflo(w.x); f[1] = bfhi(w.x); f[2] = bflo(w.y); f[3] = bfhi(w.y); f[4] = bflo(w.z); f[5] = bfhi(w.z); f[6] = bflo(w.w); f[7] = bfhi(w.w); }
__device__ __forceinline__ unsigned cvtpk(float lo, float hi) { return pg8::cvtpk(lo, hi); }
__device__ __forceinline__ u32x4 pack8f(const float* f) { u32x4 w; w.x = cvtpk(f[0], f[1]); w.y = cvtpk(f[2], f[3]); w.z = cvtpk(f[4], f[5]); w.w = cvtpk(f[6], f[7]); return w; }
__device__ __forceinline__ float silu_f(float v) { return v * __builtin_amdgcn_rcpf(1.0f + __expf(-v)); }
__device__ __forceinline__ float softplus_f(float v) { return fmaxf(v, 0.f) + log1pf(__expf(-fabsf(v))); }
__device__ __forceinline__ int crow(int r, int hi) { return (r & 3) + 8 * (r >> 2) + 4 * hi; }

__device__ __forceinline__ bf16x8 frag_row(const LAS char* img, int pitch, int row0, int k0, int lane) {
    return *(const LAS bf16x8*)(img + (row0 + (lane & 31)) * pitch + (k0 + 8 * (lane >> 5)) * 2);
}
__device__ __forceinline__ s16x4 tr4(const LAS char* p) { return __builtin_bit_cast(s16x4, __builtin_amdgcn_ds_read_tr16_b64_v4i16((LAS v4i16_t*)p)); }
__device__ __forceinline__ bf16x8 frag_tr_std(const LAS char* img, int pitch, int x0, int k0, int lane) {
    const int g = lane >> 4, i = lane & 15; const LAS char* p = img + (k0 + 8 * (g >> 1) + (i >> 2)) * pitch + (x0 + 16 * (g & 1) + 4 * (i & 3)) * 2;
    const s16x4 lo = tr4(p), hi = tr4(p + 4 * pitch);
    return (bf16x8){lo[0], lo[1], lo[2], lo[3], hi[0], hi[1], hi[2], hi[3]};
}
__device__ __forceinline__ bf16x8 frag_tr_perm(const LAS char* img, int pitch, int x0, int k0, int lane) {
    const int g = lane >> 4, i = lane & 15; const LAS char* p = img + (k0 + 4 * (g >> 1) + (i >> 2)) * pitch + (x0 + 16 * (g & 1) + 4 * (i & 3)) * 2;
    const s16x4 lo = tr4(p), hi = tr4(p + 8 * pitch);
    return (bf16x8){lo[0], lo[1], lo[2], lo[3], hi[0], hi[1], hi[2], hi[3]};
}
#define MFMA32(a, b, c) __builtin_amdgcn_mfma_f32_32x32x16_bf16((a), (b), (c), 0, 0, 0)

__device__ __forceinline__ void transpose_item(const float* W, int ldN, int k0, int n0, bf16* WT, int K, int dest_row0, LAS float* scr, int lane, const float* gk = nullptr) {
    f32x4 v[8];
#pragma unroll
    for (int i = 0; i < 8; ++i) { const int kk = 8 * i + (lane >> 3); v[i] = __builtin_nontemporal_load((const f32x4*)(W + (size_t)(k0 + kk) * ldN + n0 + 4 * (lane & 7))); }
#pragma unroll
    for (int i = 0; i < 8; ++i) { const int kk = 8 * i + (lane >> 3); const float sc_ = gk ? gk[k0 + kk] : 1.0f; LAS float* d = scr + kk * 33 + 4 * (lane & 7);
        d[0] = sc_ * v[i][0]; d[1] = sc_ * v[i][1]; d[2] = sc_ * v[i][2]; d[3] = sc_ * v[i][3]; }
    asm volatile("s_waitcnt lgkmcnt(0)" ::: "memory");
    const int c = lane & 7;
#pragma unroll
    for (int j = 0; j < 4; ++j) { const int n = (lane >> 3) + 8 * j; const LAS float* s = scr + (8 * c) * 33 + n;
        u32x4 o; o.x = cvtpk(s[0 * 33], s[1 * 33]); o.y = cvtpk(s[2 * 33], s[3 * 33]); o.z = cvtpk(s[4 * 33], s[5 * 33]); o.w = cvtpk(s[6 * 33], s[7 * 33]);
        *(u32x4*)(WT + (size_t)(dest_row0 + n0 + n) * K + k0 + 8 * c) = o; }
    asm volatile("s_waitcnt lgkmcnt(0)" ::: "memory");
}
__device__ __forceinline__ void convert_layer(const Params& p, int layer, LAS unsigned char* lds, int gw, int NGW, int wave, int lane) {
    LAS float* scr = (LAS float*)(lds + wave * 16384);
    unsigned char* wl = p.ws + WS_W0 + (size_t)layer * W_LAYER; bf16* WIN = (bf16*)(wl + WO_IN); bf16* WOUT = (bf16*)(wl + WO_OUT); bf16* WUP = (bf16*)(wl + WO_UP); bf16* WDOWN = (bf16*)(wl + WO_DOWN);
    constexpr int I_IN = 16 * 104, I_OUT = 16 * 32, I_UP = 16 * 176, I_DOWN = 44 * 32, NITEMS = I_IN + I_OUT + I_UP + I_DOWN;
    for (int it = gw; it < NITEMS; it += NGW) {
        int r = it;
        if (r < I_IN) { const int kb = r / 104, nb = r % 104; transpose_item(p.in[I_WIN] + (size_t)layer * D * IN_COLS, IN_COLS, 64 * kb, 32 * nb, WIN, D, 0, scr, lane, p.in[I_NMG] + layer * D); continue; } r -= I_IN;
        if (r < I_OUT) { const int kb = r / 32, nb = r % 32; transpose_item(p.in[I_WOUT] + (size_t)layer * D * D, D, 64 * kb, 32 * nb, WOUT, D, 0, scr, lane); continue; } r -= I_OUT;
        if (r < I_UP) { const int kb = r / 176, nb = r % 176; const int n0 = 32 * nb; const int nn = n0 < DFF ? n0 : n0 - DFF; const int drow = (nn >> 7) * 256 + (n0 < DFF ? 0 : 128) + (nn & 127);
            transpose_item(p.in[I_WUP] + (size_t)layer * D * UPW, UPW, 64 * kb, n0, WUP, D, drow - n0, scr, lane, p.in[I_NFG] + layer * D); continue; } r -= I_UP;
        { const int kb = r / 32, nb = r % 32; transpose_item(p.in[I_WDOWN] + (size_t)layer * DFF * D, D, 64 * kb, 32 * nb, WDOWN, DFF, 0, scr, lane); }
    }
}
__device__ __forceinline__ float inv_freq(int j) {
    switch (j) { case 0: return 1.0f; case 1: return 0.19392274f; case 2: return 0.03760603f; case 3: return 0.0072926646f; case 4: return 0.0014142136f; case 5: return 0.0002742482f; case 6: return 5.3182957e-05f; default: return 1.0313385e-05f; }
}

__device__ __forceinline__ void ssd1_unit(const Params& p, int layer, int b, int c, int g, LAS unsigned char* lds, int wave0) {
    unsigned mk_ = ~0u; asm volatile("" : "+s"(mk_)); int tid_raw = (int)__builtin_amdgcn_mbcnt_hi(mk_, __builtin_amdgcn_mbcnt_lo(mk_, 0u)); asm volatile("" : "+v"(tid_raw)); tid_raw += wave0 * 64; const int tid = tid_raw, wid = __builtin_amdgcn_readfirstlane(tid >> 6), lane = tid & 63, r32 = lane & 31, hi = lane >> 5;
    const int t0 = b * SEQ + c * 128;
    LAS char* XWF = (LAS char*)lds; LAS char* XWB = XWF + 40960; LAS char* BC = XWF + 81920; LAS float* sc = (LAS float*)(lds + 122880);
    const bf16* __restrict__ P = (const bf16*)(p.ws + WS_P); bf16* __restrict__ XBC = (bf16*)(p.ws + WS_XBC); const float* DT = (const float*)(p.ws + WS_DT);
    float* SSDV = (float*)(p.ws + WS_SSDV); float* CD = (float*)(p.ws + WS_CD); float* S = (float*)(p.ws + WS_S);
    if (tid < 256) { const int hh = tid >> 7, l = tid & 127, h = 2 * g + hh, t = t0 + l;
        const float dtf = softplus_f(DT[t * 8 + h] + p.in[I_DTB][layer * 8 + h]), dtb = softplus_f(DT[t * 8 + 4 + h] + p.in[I_DTB][layer * 8 + 4 + h]);
        const float A0 = -__expf(p.in[I_ALOG][layer * 8 + h]), A1 = -__expf(p.in[I_ALOG][layer * 8 + 4 + h]);
        sc[0 * 256 + tid] = dtf * A0 * LOG2E; sc[1 * 256 + tid] = dtb * A1 * LOG2E; sc[2 * 256 + tid] = dtf; sc[3 * 256 + tid] = dtb; }
    __syncthreads();
    if (wid < 4) { const int hh = wid >> 1, dir = wid & 1; LAS float* a = sc + dir * 256 + hh * 128;
        const float e0 = a[2 * lane], e1 = a[2 * lane + 1], ps = e0 + e1; float inc = ps;
#pragma unroll
        for (int o = 1; o < 64; o <<= 1) { const float tt = __builtin_bit_cast(float, __builtin_amdgcn_ds_bpermute((lane - o) << 2, __builtin_bit_cast(int, inc))); if (lane >= o) inc += tt; }
        const float exc = inc - ps, c0 = exc + e0, c1 = exc + ps, tot = __builtin_bit_cast(float, __builtin_amdgcn_readlane(__builtin_bit_cast(int, inc), 63));
        if (dir == 0) { sc[6 * 256 + hh * 128 + 2 * lane] = c0; sc[6 * 256 + hh * 128 + 2 * lane + 1] = c1; }
        else { sc[7 * 256 + hh * 128 + 2 * lane] = tot - c0 + e0; sc[7 * 256 + hh * 128 + 2 * lane + 1] = tot - c1 + e1; } }
    __syncthreads();
    if (tid < 256) { const int hh = tid >> 7, l = tid & 127, h = 2 * g + hh, t = t0 + l;
        const float fc = sc[6 * 256 + tid], rc = sc[7 * 256 + tid], dtf = sc[2 * 256 + tid], dtb = sc[3 * 256 + tid];
        const float ftot = sc[6 * 256 + hh * 128 + 127], rtot = sc[7 * 256 + hh * 128];
        sc[4 * 256 + tid] = __builtin_amdgcn_exp2f(ftot - fc) * dtf; sc[5 * 256 + tid] = __builtin_amdgcn_exp2f(rtot - rc) * dtb;
        *(f32x4*)(SSDV + ((size_t)t * 4 + h) * 4) = (f32x4){fc, rc, dtf, dtb};
        if (l == 0) { CD[((b * 32 + c) * 4 + h) * 2 + 0] = __builtin_amdgcn_exp2f(ftot); CD[((b * 32 + c) * 4 + h) * 2 + 1] = __builtin_amdgcn_exp2f(rtot); } }
    __syncthreads();
    const float* cw = p.in[I_SSDW] + (size_t)layer * 3 * 768; const float* cb = p.in[I_SSDB] + (size_t)layer * 768;
#pragma unroll 4
    for (int it = tid; it < 128 * 48; it += NTHREADS) {
        const int l = it / 48, cch = it % 48, seg = cch >> 4, cc = cch & 15, ch0 = seg * 256 + 128 * g + 8 * cc, s = c * 128 + l, t = t0 + l;
        const bf16* src = P + (size_t)t * 1792 + 1024 + ch0;
        u32x4 r0 = {0u, 0u, 0u, 0u}, r2 = r0; const u32x4 r1 = *(const u32x4*)src;
        if (s > 0) r0 = *(const u32x4*)(src - 1792); if (s < SEQ - 1) r2 = *(const u32x4*)(src + 1792);
        float x0[8], x1[8], x2[8], v[8]; unpack8(r0, x0); unpack8(r1, x1); unpack8(r2, x2);
        float w0[8], w1[8], w2[8], bb[8];
        *(f32x4*)&w0[0] = *(const f32x4*)(cw + ch0); *(f32x4*)&w0[4] = *(const f32x4*)(cw + ch0 + 4);
        *(f32x4*)&w1[0] = *(const f32x4*)(cw + 768 + ch0); *(f32x4*)&w1[4] = *(const f32x4*)(cw + 768 + ch0 + 4);
        *(f32x4*)&w2[0] = *(const f32x4*)(cw + 1536 + ch0); *(f32x4*)&w2[4] = *(const f32x4*)(cw + 1536 + ch0 + 4);
        *(f32x4*)&bb[0] = *(const f32x4*)(cb + ch0); *(f32x4*)&bb[4] = *(const f32x4*)(cb + ch0 + 4);
#pragma unroll
        for (int j = 0; j < 8; ++j) v[j] = silu_f(bb[j] + w0[j] * x0[j] + w1[j] * x1[j] + w2[j] * x2[j]);
        *(u32x4*)(XBC + (size_t)t * 768 + ch0) = pack8f(v);
        if (seg == 0) { const int hh = cc >> 3; const float wf = sc[4 * 256 + hh * 128 + l], wb = sc[5 * 256 + hh * 128 + l]; float vf[8], vb[8];
#pragma unroll
            for (int j = 0; j < 8; ++j) { vf[j] = v[j] * wf; vb[j] = v[j] * wb; }
            *(LAS u32x4*)(XWF + l * 320 + cc * 16) = pack8f(vf); *(LAS u32x4*)(XWB + l * 320 + cc * 16) = pack8f(vb); }
        else if (seg == 1) { *(LAS u32x4*)(BC + l * 320 + cc * 16) = pack8f(v); }
    }
    __syncthreads();
    { const int dir = wid >> 2, hh = (wid >> 1) & 1, pt = wid & 1, h = 2 * g + hh; const LAS char* img = dir ? XWB : XWF;
        f32x16 acc[4] = {};
#pragma unroll
        for (int kk = 0; kk < 8; ++kk) { const bf16x8 A = frag_tr_std(img, 320, 64 * hh + 32 * pt, 16 * kk, lane);
#pragma unroll
            for (int nt = 0; nt < 4; ++nt) { const bf16x8 B = frag_tr_std(BC, 320, 32 * nt, 16 * kk, lane); acc[nt] = MFMA32(A, B, acc[nt]); } }
        float* Sp = S + ((size_t)(((b * 32 + c) * 4 + h) * 2 + dir)) * 8192;
#pragma unroll
        for (int nt = 0; nt < 4; ++nt)
#pragma unroll
            for (int r = 0; r < 16; ++r) Sp[(32 * pt + crow(r, hi)) * 128 + 32 * nt + r32] = acc[nt][r];
    }
    __syncthreads();
}

__device__ __forceinline__ void ssd3_unit(const Params& p, int layer, int b, int c, int g, LAS unsigned char* lds, int wave0) {
    unsigned mk_ = ~0u; asm volatile("" : "+s"(mk_)); int tid_raw = (int)__builtin_amdgcn_mbcnt_hi(mk_, __builtin_amdgcn_mbcnt_lo(mk_, 0u)); asm volatile("" : "+v"(tid_raw)); tid_raw += wave0 * 64; const int tid = tid_raw, wid = __builtin_amdgcn_readfirstlane(tid >> 6), lane = tid & 63, r32 = lane & 31, hi = lane >> 5;
    const int t0 = b * SEQ + c * 128;
    LAS float* sc = (LAS float*)lds; LAS char* CI = (LAS char*)lds + 8192; LAS char* XS = CI + 34816; LAS char* BI = XS + 40960; LAS char* HI = BI;
    const bf16* P = (const bf16*)(p.ws + WS_P); const bf16* XBC = (const bf16*)(p.ws + WS_XBC); const float* SSDV = (const float*)(p.ws + WS_SSDV);
    const float* S = (const float*)(p.ws + WS_S); bf16* Y = (bf16*)(p.ws + WS_Y);
    f32x4 hreg[16];
    { const float* Sb = S + ((size_t)((b * 32 + c) * 4 + 2 * g) * 2) * 8192;
#pragma unroll
        for (int i = 0; i < 16; ++i) { const int idx = tid + NTHREADS * i; hreg[i] = *(const f32x4*)(Sb + (size_t)(idx >> 11) * 8192 + (idx & 2047) * 4); } }
#pragma unroll 6
    for (int it = tid; it < 128 * 48; it += NTHREADS) {
        const int l = it / 48, cch = it % 48, seg = cch >> 4, cc = cch & 15;
        const u32x4 v = *(const u32x4*)(XBC + (size_t)(t0 + l) * 768 + seg * 256 + 128 * g + 8 * cc);
        if (seg == 0) *(LAS u32x4*)(XS + l * 320 + cc * 16) = v; else if (seg == 1) *(LAS u32x4*)(BI + l * 272 + cc * 16) = v; else *(LAS u32x4*)(CI + l * 272 + cc * 16) = v;
    }
    if (tid < 256) { const int hh = tid >> 7, l = tid & 127, h = 2 * g + hh; const f32x4 sv = *(const f32x4*)(SSDV + ((size_t)(t0 + l) * 4 + h) * 4);
        sc[0 * 256 + tid] = sv[0]; sc[1 * 256 + tid] = sv[1]; sc[2 * 256 + tid] = sv[0] - __log2f(sv[2]); sc[3 * 256 + tid] = sv[1] - __log2f(sv[3]); }
    __syncthreads();
    const int lb = wid & 3, hh = wid >> 2, h = 2 * g + hh;
    f32x16 X[4] = {};
#pragma unroll
    for (int kk = 0; kk < 8; ++kk) { const bf16x8 Bf = frag_row(CI, 272, 32 * lb, 16 * kk, lane);
#pragma unroll
        for (int st = 0; st < 4; ++st) { const bf16x8 Af = frag_row(BI, 272, 32 * st, 16 * kk, lane); X[st] = MFMA32(Af, Bf, X[st]); } }
    __syncthreads();
    {
#pragma unroll
        for (int i = 0; i < 16; ++i) { const int idx = tid + NTHREADS * i, img = idx >> 11, e = (idx & 2047) * 4, pp = e >> 7, n = e & 127;
            u32x2 w; w.x = cvtpk(hreg[i][0], hreg[i][1]); w.y = cvtpk(hreg[i][2], hreg[i][3]);
            *(LAS u32x2*)(HI + img * 17408 + pp * 272 + n * 2) = w; } }
    __syncthreads();
    const int l = 32 * lb + r32; const float fl = sc[0 * 256 + hh * 128 + l], rl = sc[1 * 256 + hh * 128 + l]; const float Dh = p.in[I_SSDD][layer * 4 + h];
    f32x16 y[2] = {};
#pragma unroll
    for (int st = 0; st < 4; ++st) {
        bf16x8 wfr[2];
#pragma unroll
        for (int ss = 0; ss < 2; ++ss) { unsigned w[4];
#pragma unroll
            for (int jj = 0; jj < 4; ++jj) { float val[2];
#pragma unroll
                for (int q = 0; q < 2; ++q) { const int r = 8 * ss + 2 * jj + q, s = 32 * st + crow(r, hi);
                    const float ef = sc[2 * 256 + hh * 128 + s], eb = sc[3 * 256 + hh * 128 + s];
                    const float f1 = __builtin_amdgcn_exp2f(fl - ef), f2 = __builtin_amdgcn_exp2f(rl - eb);
                    const float fac = (s <= l ? f1 : 0.f) + (s >= l ? f2 : 0.f);
                    val[q] = X[st][r] * fac + (s == l ? Dh : 0.f); }
                w[jj] = cvtpk(val[0], val[1]); }
            const u32x4 ww = {w[0], w[1], w[2], w[3]}; wfr[ss] = __builtin_bit_cast(bf16x8, ww); }
#pragma unroll
        for (int ss = 0; ss < 2; ++ss)
#pragma unroll
            for (int pt = 0; pt < 2; ++pt) { const bf16x8 Af = frag_tr_perm(XS, 320, 64 * hh + 32 * pt, 32 * st + 16 * ss, lane); y[pt] = MFMA32(Af, wfr[ss], y[pt]); }
    }
#pragma unroll
    for (int dir = 0; dir < 2; ++dir) { f32x16 yo[2] = {};
#pragma unroll
        for (int kk = 0; kk < 8; ++kk) { const bf16x8 Bf = frag_row(CI, 272, 32 * lb, 16 * kk, lane);
#pragma unroll
            for (int pt = 0; pt < 2; ++pt) { const bf16x8 Af = frag_row(HI + (hh * 2 + dir) * 17408, 272, 32 * pt, 16 * kk, lane); yo[pt] = MFMA32(Af, Bf, yo[pt]); } }
        const float el = __builtin_amdgcn_exp2f(dir ? rl : fl);
#pragma unroll
        for (int pt = 0; pt < 2; ++pt)
#pragma unroll
            for (int r = 0; r < 16; ++r) y[pt][r] += el * yo[pt][r];
    }
    const size_t t = (size_t)t0 + l; float ssq = 0.f;
#pragma unroll
    for (int pt = 0; pt < 2; ++pt)
#pragma unroll
        for (int q4 = 0; q4 < 4; ++q4) { const int pp = 32 * pt + 8 * q4 + 4 * hi; const u32x2 zz = *(const u32x2*)(P + t * 1792 + 768 + 128 * g + 64 * hh + pp);
            const float z0 = bflo(zz.x), z1 = bfhi(zz.x), z2 = bflo(zz.y), z3 = bfhi(zz.y);
            y[pt][4 * q4 + 0] *= silu_f(z0); y[pt][4 * q4 + 1] *= silu_f(z1); y[pt][4 * q4 + 2] *= silu_f(z2); y[pt][4 * q4 + 3] *= silu_f(z3);
#pragma unroll
            for (int q = 0; q < 4; ++q) ssq += y[pt][4 * q4 + q] * y[pt][4 * q4 + q]; }
    ssq = lx_sum32(ssq);
    if (hi == 0) sc[4 * 256 + hh * 128 + l] = ssq;
    __syncthreads();
    const float tot = sc[4 * 256 + l] + sc[4 * 256 + 128 + l]; const float rstd = __builtin_amdgcn_rsqf(tot * (1.0f / 128.0f) + 1e-5f);
    const float* ng = p.in[I_SSDNG] + layer * 256 + 128 * g + 64 * hh;
#pragma unroll
    for (int pt = 0; pt < 2; ++pt)
#pragma unroll
        for (int q4 = 0; q4 < 4; ++q4) { const int pp = 32 * pt + 8 * q4 + 4 * hi; const f32x4 gg = *(const f32x4*)(ng + pp);
            u32x2 w; w.x = cvtpk(y[pt][4 * q4 + 0] * rstd * gg[0], y[pt][4 * q4 + 1] * rstd * gg[1]); w.y = cvtpk(y[pt][4 * q4 + 2] * rstd * gg[2], y[pt][4 * q4 + 3] * rstd * gg[3]);
            *(u32x2*)(Y + t * 1024 + 768 + 128 * g + 64 * hh + pp) = w; }
    __syncthreads();
}
#ifndef PHASE_MASK
#define PHASE_MASK 0xFFFF
#endif
#define PEN(i) ((PHASE_MASK >> (i)) & 1)
#ifndef REP_CVT
#define REP_CVT 1
#endif
#ifndef REP_IN
#define REP_IN 1
#endif
#ifndef REP_MIXA
#define REP_MIXA 1
#endif
#ifndef REP_ATT
#define REP_ATT 1
#endif
#ifndef REP_MIXC
#define REP_MIXC 1
#endif
#ifndef REP_UP
#define REP_UP 1
#endif
constexpr int PH_PRO = 0, PH_PER_LAYER = 7, PH_FINAL = 1 + PH_PER_LAYER * DEPTH, NPH = PH_FINAL + 1;
enum { LP_IN = 0, LP_MIXA, LP_MIXB, LP_MIXC, LP_OUT, LP_UP, LP_DOWN };

__global__ void __launch_bounds__(NTHREADS, 2) fwd_kernel(Params p) {
    extern __shared__ __attribute__((aligned(16))) unsigned char lds_raw[];
    LAS unsigned char* lds = (LAS unsigned char*)lds_raw;
    const int G = gridDim.x, bx = blockIdx.x, vcu = (G % 8 == 0) ? (bx % 8) * (G / 8) + bx / 8 : bx;
    const int NGW = G * NWAVES, NGT = G * NTHREADS;
    const int wave0 = __builtin_amdgcn_readfirstlane(threadIdx.x >> 6);
#define LOCALS unsigned mk_ = ~0u; asm volatile("" : "+s"(mk_)); int tid_r = (int)__builtin_amdgcn_mbcnt_hi(mk_, __builtin_amdgcn_mbcnt_lo(mk_, 0u)); asm volatile("" : "+v"(tid_r)); tid_r += wave0 * 64; const int tid = tid_r, lane = tid & 63, wave = __builtin_amdgcn_readfirstlane(tid >> 6), gw = vcu * NWAVES + wave, gtid = vcu * NTHREADS + tid; (void)lane; (void)gw; (void)gtid;
    volatile LAS unsigned* MISC = (volatile LAS unsigned*)(lds + LDSCTL_OFF);
    { LOCALS for (int u = tid; u < (LDS_BYTES - LDSCTL_OFF) / 4; u += NTHREADS) ((LAS unsigned*)(lds + LDSCTL_OFF))[u] = 0u; }
    __syncthreads();
    unsigned* ctl = (unsigned*)(p.ws + WS_CTL);
    const bool multi = (p.ph_hi - p.ph_lo) > 1;
    XcdBarrier bar; bar.w0 = wave0; bar.bar = ctl + CW_BAR; bar.x = 0; bar.st = nullptr;
    if (multi) bar = xcd_barrier_post(ctl + CW_BAR, MISC + 8, wave0);
#define IN(k) (p.ph_lo <= (k) && (k) < p.ph_hi)
#define SEAM(k) do { if (p.ph_lo <= (k) && (k) + 1 < p.ph_hi) xcd_barrier(bar); } while (0)

#define XO (p.out)
#define XG ((bf16*)(p.ws + WS_XG))
#define RSS ((float*)(p.ws + WS_RSS))
#define COS ((float*)(p.ws + WS_COS))
#define SIN ((float*)(p.ws + WS_SIN))
#define Qb ((bf16*)(p.ws + WS_Q))
#define Kb ((bf16*)(p.ws + WS_K))
#define Vb ((bf16*)(p.ws + WS_V))
#define Pb ((bf16*)(p.ws + WS_P))
#define Yb ((bf16*)(p.ws + WS_Y))
#define DT ((float*)(p.ws + WS_DT))
#define A2 ((bf16*)(p.ws + WS_A2))
#define WIN ((bf16*)(p.ws + WS_W0 + (size_t)layer * W_LAYER + WO_IN))
#define WOUT ((bf16*)(p.ws + WS_W0 + (size_t)layer * W_LAYER + WO_OUT))
#define WUP ((bf16*)(p.ws + WS_W0 + (size_t)layer * W_LAYER + WO_UP))
#define WDOWN ((bf16*)(p.ws + WS_W0 + (size_t)layer * W_LAYER + WO_DOWN))

    if (PEN(0) && IN(PH_PRO)) { LOCALS
        const int* pos = (const int*)p.in[I_POS];
        for (int i = gtid; i < M * 8; i += NGT) { const int row = i >> 3, j = i & 7; const float ang = (float)pos[row] * inv_freq(j);
            const double rev = (double)ang * 0.15915494309189535; const double fr = rev - __builtin_rint(rev); const float a = (float)(fr * 6.283185307179586);
            COS[i] = cosf(a); SIN[i] = sinf(a); }
        for (int rep = 0; rep < REP_CVT; ++rep) convert_layer(p, 0, lds, gw, NGW, wave, lane);
        __syncthreads();
        for (int m = gw; m < M; m += NGW) { const f32x4* xr = (const f32x4*)(p.in[I_X] + (size_t)m * D) + lane; float ss = 0.f; u32x2* o8 = (u32x2*)(XG + (size_t)m * D) + lane;
#pragma unroll
            for (int j = 0; j < 4; ++j) { const f32x4 v = xr[64 * j]; ss += (v[0] * v[0] + v[1] * v[1]) + (v[2] * v[2] + v[3] * v[3]);
                u32x2 w; w.x = cvtpk(v[0], v[1]); w.y = cvtpk(v[2], v[3]); o8[64 * j] = w; }
            ss = wave_sum(ss); if (lane < 16) RSS[(size_t)m * 16 + lane] = lane == 0 ? ss : 0.f; }
    }
    if (multi && p.ph_lo <= PH_PRO && PH_PRO + 1 < p.ph_hi) cg::this_grid().sync();

    for (int layer = 0; layer < DEPTH; ++layer) {
        const int pb = 1 + PH_PER_LAYER * layer;
        const float lam_init = layer == 0 ? 0.2f : layer == 1 ? 0.35550906759f : layer == 2 ? 0.47071301834f : 0.55605820416f;
        if (PEN(2) && IN(pb + LP_IN)) {
            { LOCALS
            if (bx == 0 && tid < 32) ((unsigned*)(p.ws + WS_KMAX))[tid] = 0u;
            {
                const float* wsrc = p.in[I_WIN] + (size_t)layer * D * IN_COLS + IN_MAIN; float w[16][8];
#pragma unroll
                for (int i = 0; i < 16; ++i) { const float gk_ = p.in[I_NMG][layer * D + 16 * lane + i]; const f32x4 a = *(const f32x4*)(wsrc + (size_t)(16 * lane + i) * IN_COLS) * gk_, b = *(const f32x4*)(wsrc + (size_t)(16 * lane + i) * IN_COLS + 4) * gk_;
                    w[i][0] = a[0]; w[i][1] = a[1]; w[i][2] = a[2]; w[i][3] = a[3]; w[i][4] = b[0]; w[i][5] = b[1]; w[i][6] = b[2]; w[i][7] = b[3]; }
                for (int m = gw; m < M; m += NGW) { const u32x4 a = *(const u32x4*)(XG + (size_t)m * D + 16 * lane), b = *(const u32x4*)(XG + (size_t)m * D + 16 * lane + 8);
                    float xv[16]; unpack8(a, xv); unpack8(b, xv + 8); float acc[8];
#pragma unroll
                    for (int j = 0; j < 8; ++j) acc[j] = 0.f;
#pragma unroll
                    for (int i = 0; i < 16; ++i)
#pragma unroll
                        for (int j = 0; j < 8; ++j) acc[j] += xv[i] * w[i][j];
                    float s = lane < 16 ? RSS[(size_t)m * 16 + lane] : 0.f; s = wave_sum(s); const float rs = __builtin_amdgcn_rsqf(s * (1.0f / 1024.0f) + 1e-5f);
                    float outv = 0.f;
#pragma unroll
                    for (int j = 0; j < 8; ++j) { const float t = wave_sum(acc[j]); if (lane == j) outv = t; }
                    if (lane < 8) DT[(size_t)m * 8 + lane] = outv * rs; }
            } }
            pg8::Gemm g{XG, WIN, M, IN_MAIN, D}; pg8::StaticOrder S; S.init(M, IN_MAIN, G, bx);
            pg8::EpiIn E{RSS, COS, SIN, Qb, Kb, Vb, Pb};
            const int nfull = (64 * 13) % G, nidle = G - nfull;
            if (layer + 1 < DEPTH && nidle > 0 && nfull > 0) { if (bx >= nfull) { LOCALS convert_layer(p, layer + 1, lds, (bx - nfull) * NWAVES + wave, nidle * NWAVES, wave, lane); } __syncthreads(); }
            for (int rep = 0; rep < REP_IN; ++rep) pg8::gemm_phase<pg8::EpiIn, pg8::StaticOrder, true, true>(lds, g, S, E, wave0);
            if (layer + 1 < DEPTH && !(nidle > 0 && nfull > 0)) { { LOCALS convert_layer(p, layer + 1, lds, gw, NGW, wave, lane); } __syncthreads(); }
        }
        SEAM(pb + LP_IN);
        if (PEN(3) && IN(pb + LP_MIXA)) { LOCALS
            {
                unsigned* KMAX = (unsigned*)(p.ws + WS_KMAX); LAS float* red = (LAS float*)(lds + 155648);
                for (int i0 = vcu * NTHREADS; i0 < M * 8; i0 += NGT) { const int i = i0 + tid, t = i >> 3, hc = i & 7; const bf16* kp = Kb + (size_t)t * 512 + hc * 64; float ss = 0.f;
#pragma unroll
                    for (int j = 0; j < 8; ++j) { float f[8]; unpack8(*(const u32x4*)(kp + 8 * j), f);
#pragma unroll
                        for (int e = 0; e < 8; ++e) ss += f[e] * f[e]; }
                    ss = fmaxf(ss, lx_get(ss, lane, 8)); ss = fmaxf(ss, lx_get(ss, lane, 16)); ss = lx_max32(ss);
                    if (lane < 8) red[wave * 8 + lane] = ss;
                    __syncthreads();
                    if (tid < 8) { float m = red[tid];
#pragma unroll
                        for (int w = 1; w < 8; ++w) m = fmaxf(m, red[w * 8 + tid]);
                        atomicMax(KMAX + (i0 >> 15) * 8 + tid, __float_as_uint(m)); }
                    __syncthreads(); }
            }
            for (int rep = 0; rep < REP_MIXA; ++rep) for (int u = vcu; u < 256; u += G) ssd1_unit(p, layer, u >> 6, (u >> 1) & 31, u & 1, lds, wave0);
            const float* scw = p.in[I_SCW] + (size_t)layer * 3 * 256;
            const bf16* __restrict__ Pr_ = Pb; bf16* __restrict__ Yr_ = Yb;
#pragma unroll 4
            for (int it = gtid; it < M * 32; it += NGT) { const int t = it >> 5, cc = it & 31, s = t & (SEQ - 1); const bf16* src = Pr_ + (size_t)t * 1792 + 8 * cc;
                float bv[8], c0[8], c1[8], c2[8], h0[8], h1[8], h2[8], o[8]; const u32x4 z4 = {0u, 0u, 0u, 0u};
                unpack8(*(const u32x4*)src, bv); unpack8(*(const u32x4*)(src + 256), c1); unpack8(*(const u32x4*)(src + 512), h1);
                unpack8(s > 0 ? *(const u32x4*)(src - 1792 + 256) : z4, c0); unpack8(s > 0 ? *(const u32x4*)(src - 1792 + 512) : z4, h0);
                unpack8(s < SEQ - 1 ? *(const u32x4*)(src + 1792 + 256) : z4, c2); unpack8(s < SEQ - 1 ? *(const u32x4*)(src + 1792 + 512) : z4, h2);
#pragma unroll
                for (int j = 0; j < 8; ++j) o[j] = bv[j] * (scw[8 * cc + j] * (c0[j] * h0[j]) + scw[256 + 8 * cc + j] * (c1[j] * h1[j]) + scw[512 + 8 * cc + j] * (c2[j] * h2[j]));
                *(u32x4*)(Yr_ + (size_t)t * 1024 + 512 + 8 * cc) = pack8f(o); }
        }
        SEAM(pb + LP_MIXA);
        if (PEN(4) && IN(pb + LP_MIXB)) {
            { LOCALS float* S = (float*)(p.ws + WS_S); const float* CD = (const float*)(p.ws + WS_CD);
                for (int i = gtid; i < 32 * 4096; i += NGT) { const int bhd = i >> 12, e = (i & 4095) * 2, b = bhd >> 3, h = (bhd >> 1) & 3, dir = bhd & 1;
                    typedef float f32x2_ __attribute__((ext_vector_type(2)));
                    f32x2_ st[32]; float dec[32]; const int cmask = dir ? 31 : 0;
#pragma unroll
                    for (int cc = 0; cc < 32; ++cc) { const int c = cc ^ cmask; st[cc] = *(const f32x2_*)(S + ((size_t)(((b * 32 + c) * 4 + h) * 2 + dir)) * 8192 + e); dec[cc] = CD[((b * 32 + c) * 4 + h) * 2 + dir]; }
                    float z0_ = 0.f; asm volatile("" : "+v"(z0_)); f32x2_ hs = {z0_, z0_};
#pragma unroll
                    for (int cc = 0; cc < 32; ++cc) { const int c = cc ^ cmask; *(f32x2_*)(S + ((size_t)(((b * 32 + c) * 4 + h) * 2 + dir)) * 8192 + e) = hs; hs = hs * dec[cc] + st[cc]; } } }
            asm volatile("s_waitcnt vmcnt(0)" ::: "memory");
            __syncthreads();
            if (multi && wave0 == 0 && xb_lane0()) { __builtin_amdgcn_fence(__ATOMIC_RELEASE, "agent"); asm volatile("s_waitcnt vmcnt(0)" ::: "memory"); (void)xb_add(ctl + CW_SCAN + layer, 1u); }
            float lam;
            { LOCALS const float a = wave_sum(p.in[I_LQ1][layer * 64 + lane] * p.in[I_LK1][layer * 64 + lane]), b2 = wave_sum(p.in[I_LQ2][layer * 64 + lane] * p.in[I_LK2][layer * 64 + lane]);
                lam = __builtin_bit_cast(float, __builtin_amdgcn_readfirstlane(__builtin_bit_cast(int, __expf(a) - __expf(b2) + lam_init))); }
#define ATT_UNIT(UID) do { const int uid_ = (UID), b = uid_ >> 6, h = (uid_ >> 4) & 3, qb = uid_ & 15; \
                attn::attn_unit2(Qb, Kb, Vb, Yb, b, h, qb * 256, lam, lam_init_s, p.in[I_SUBG] + layer * 128, (const unsigned*)(p.ws + WS_KMAX), (attn::lchar*)lds, wave0); } while (0)
            const float lam_init_s = __builtin_bit_cast(float, __builtin_amdgcn_readfirstlane(__builtin_bit_cast(int, lam_init)));
            for (int rep = 0; rep < REP_ATT; ++rep) {
                if (G >= 256) { if (vcu < 256) ATT_UNIT(vcu); }
                else for (int uid = vcu; uid < 256; uid += G) ATT_UNIT(uid); }
#undef ATT_UNIT
        }
        if (!multi) SEAM(pb + LP_MIXB);
        else if (IN(pb + LP_MIXB) && IN(pb + LP_MIXC)) {
            if (wave0 == 0 && xb_lane0()) { unsigned* sc_ = ctl + CW_SCAN + layer; XB_SPIN(xb_ld(sc_) < (unsigned)G, bar.bar); __builtin_amdgcn_fence(__ATOMIC_ACQUIRE, "agent"); asm volatile("s_waitcnt vmcnt(0)" ::: "memory"); }
            __syncthreads(); }
        if (PEN(5) && IN(pb + LP_MIXC)) { for (int rep = 0; rep < REP_MIXC; ++rep) for (int u = vcu; u < 256; u += G) ssd3_unit(p, layer, u >> 6, (u >> 1) & 31, u & 1, lds, wave0); }
        SEAM(pb + LP_MIXC);
        if (PEN(6) && IN(pb + LP_OUT)) {
            pg8::Gemm g{Yb, WOUT, M, D, D}; pg8::StaticOrder S; S.init(M, D, G, bx);
            pg8::EpiRes E{XG, RSS};
            pg8::gemm_phase<pg8::EpiRes, pg8::StaticOrder, true, true>(lds, g, S, E, wave0);
        }
        SEAM(pb + LP_OUT);
        if (PEN(7) && IN(pb + LP_UP)) {
            pg8::Gemm g{XG, WUP, 68 * 256, UPW, D}; pg8::StaticOrder S; S.init(68 * 256, UPW, G, bx);
            pg8::EpiUpConv E{RSS, p.in[I_FCW] + (size_t)layer * 3 * UPW, p.in[I_FCB] + (size_t)layer * UPW, A2, (LAS float*)(lds + 147456), (LAS float*)(lds + 131072)};
            for (int rep = 0; rep < REP_UP; ++rep) pg8::gemm_phase<pg8::EpiUpConv, pg8::StaticOrder, true, true, 1>(lds, g, S, E, wave0);
        }
        SEAM(pb + LP_UP);
        if (PEN(9) && IN(pb + LP_DOWN)) {
            pg8::Gemm g{A2, WDOWN, M, D, DFF}; pg8::StaticOrder S; S.init(M, D, G, bx);
            pg8::EpiRes E{XG, RSS};
            pg8::gemm_phase<pg8::EpiRes, pg8::StaticOrder, true, true>(lds, g, S, E, wave0);
        }
        SEAM(pb + LP_DOWN);
    }
    if (PEN(10) && IN(PH_FINAL)) { LOCALS
        const float* gf = p.in[I_FNG];
        for (int m = gw; m < M; m += NGW) { float s = lane < 16 ? RSS[(size_t)m * 16 + lane] : 0.f; s = wave_sum(s); const float rs = __builtin_amdgcn_rsqf(s * (1.0f / 1024.0f) + 1e-5f);
            const u32x2* xr = (const u32x2*)(XG + (size_t)m * D) + lane; f32x4* orow = (f32x4*)(XO + (size_t)m * D) + lane;
#pragma unroll
            for (int j = 0; j < 4; ++j) { const u32x2 w = xr[64 * j]; const f32x4 v = {bflo(w.x), bfhi(w.x), bflo(w.y), bfhi(w.y)}; const f32x4 gg = *((const f32x4*)gf + lane + 64 * j); orow[64 * j] = v * gg * rs; } }
    }
#undef IN
#undef SEAM
}

__global__ void fill_kernel(float* o, int n, float v) { for (int i = blockIdx.x * blockDim.x + threadIdx.x; i < n; i += gridDim.x * blockDim.x) o[i] = v; }

#ifndef N_LAUNCH_MODE
#define N_LAUNCH_MODE 1
#endif
extern "C" void kernel_launch(void* const* d_in, const int* in_sizes, int n_in, void* d_out, int out_size, void* d_ws, size_t ws_size, hipStream_t stream) {
    static int grid = 0;
    if (grid == 0) {
        if (n_in != 23 || in_sizes[0] != M * D || out_size != M * D || ws_size < WS_END) {
            fprintf(stderr, "kernel_launch: unexpected shapes / workspace: n_in %d in0 %d out %d ws %zu (need %zu)\n", n_in, n_in > 0 ? in_sizes[0] : -1, out_size, ws_size, (size_t)WS_END);
            grid = -1;
        } else {
            int dev = 0, cus = 0, per_cu = 0;
            hipGetDevice(&dev); hipDeviceGetAttribute(&cus, hipDeviceAttributeMultiprocessorCount, dev);
            hipFuncSetAttribute((const void*)fwd_kernel, hipFuncAttributeMaxDynamicSharedMemorySize, LDS_BYTES);
            hipOccupancyMaxActiveBlocksPerMultiprocessor(&per_cu, (const void*)fwd_kernel, NTHREADS, LDS_BYTES);
            (void)hipGetLastError();
            if (per_cu < 1) { fprintf(stderr, "kernel_launch: occupancy query reports %d blocks per CU\n", per_cu); grid = -1; }
            else grid = cus;
        }
    }
    if (grid < 0) { hipLaunchKernelGGL(fill_kernel, dim3(256), dim3(256), 0, stream, (float*)d_out, out_size, 1.0e30f); return; }
    hipMemsetAsync((char*)d_ws + WS_CTL, 0, CTL_ZERO_BYTES, stream);
    Params a{};
    for (int i = 0; i < 23; ++i) a.in[i] = (const float*)d_in[i];
    a.out = (float*)d_out; a.ws = (unsigned char*)d_ws;
#if N_LAUNCH_MODE == 0
    for (int ph = 0; ph < NPH; ++ph) { a.ph_lo = ph; a.ph_hi = ph + 1; hipLaunchKernelGGL(fwd_kernel, dim3(grid), dim3(NTHREADS), LDS_BYTES, stream, a); }
#else
    a.ph_lo = 0; a.ph_hi = NPH; void* args[] = {&a};
    hipError_t e = hipLaunchCooperativeKernel((const void*)fwd_kernel, dim3(grid), dim3(NTHREADS), args, LDS_BYTES, stream);
    if (e != hipSuccess) fprintf(stderr, "cooperative launch failed: %s (grid %d)\n", hipGetErrorString(e), grid);
#endif
}
```

```cpp
#include <hip/hip_runtime.h>
#include <hip/hip_cooperative_groups.h>
#include <cstdio>
#include <cstdint>
namespace cg = cooperative_groups;
__device__ __forceinline__ float lx_get(float v, int lane, int o) { return __builtin_bit_cast(float, __builtin_amdgcn_ds_bpermute((lane ^ o) << 2, __builtin_bit_cast(int, v))); }
__device__ __forceinline__ float lx_sum32(float v) { const unsigned a = __builtin_bit_cast(unsigned, v); auto r = __builtin_amdgcn_permlane32_swap(a, a, false, false); const unsigned r0 = r[0], r1 = r[1]; return __builtin_bit_cast(float, r0) + __builtin_bit_cast(float, r1); }
__device__ __forceinline__ float lx_max32(float v) { const unsigned a = __builtin_bit_cast(unsigned, v); auto r = __builtin_amdgcn_permlane32_swap(a, a, false, false); const unsigned r0 = r[0], r1 = r[1]; return fmaxf(__builtin_bit_cast(float, r0), __builtin_bit_cast(float, r1)); }
#define LX_DPP(v, ctrl) __builtin_bit_cast(float, __builtin_amdgcn_update_dpp(0, __builtin_bit_cast(int, (v)), (ctrl), 0xf, 0xf, false))
__device__ __forceinline__ float wave_sum_l(float v, int lane) {
#pragma unroll
    for (int o = 1; o < 32; o <<= 1) v += lx_get(v, lane, o);
    return lx_sum32(v);
}
#define wave_sum(v) wave_sum_l((v), lane)

namespace pg8 {
#define PG8_LAS __attribute__((address_space(3)))
typedef unsigned short bf16_t;
typedef short bf16x8 __attribute__((ext_vector_type(8)));
typedef float f32x4 __attribute__((ext_vector_type(4)));
typedef unsigned u32x4 __attribute__((ext_vector_type(4)));
constexpr int BM = 256, BK = 64, HALF = 128, HTB = HALF * BK * 2  , STAGE_BYTES = 8 * HTB, NXCD = 8, WGM = 8;

__host__ __device__ __forceinline__ int lds_byte(int r, int c) { const int st = (r >> 4) * 2 + (c >> 5), rr = r & 15, cc = c & 31, ob = rr * 64 + cc * 2; return st * 1024 + (ob ^ (((ob >> 9) & 1) << 5)); }
__host__ __device__ __forceinline__ void stage_rc(int b, int& R, int& C) { const int st = b / 1024, sb = b % 1024, swz = sb ^ (((sb >> 9) & 1) << 5); R = (st >> 1) * 16 + swz / 64; C = (st & 1) * 32 + (swz % 64) / 2; }
__host__ __device__ __forceinline__ int perm32(int rho) { const int n = rho >> 4, i = rho & 15; return 8 * (i >> 2) + 4 * n + (i & 3); }

struct Unit { int pm, pn; };
struct Gemm { const bf16_t* A; const bf16_t* Bt; int M, N, K; };

struct StaticOrder {
    int nM, nN, nwg, G, c;
    __host__ __device__ void init(int M, int N, int G_, int c_) { nM = M / BM; nN = N / BM; nwg = nM * nN; G = G_; c = c_; }
    __host__ __device__ bool next(int i, Unit& u) const {
        const int L = i * G + c; if (L >= nwg) return false;
        int wgid = L; { const int q = nwg / NXCD, r = nwg % NXCD, xcd = wgid % NXCD, off = wgid / NXCD; wgid = (xcd < r ? xcd * (q + 1) : r * (q + 1) + (xcd - r) * q) + off; }
        const int nig = WGM * nN, gid = wgid / nig, fm = gid * WGM, gsz = (nM - fm) < WGM ? (nM - fm) : WGM;
        u.pm = fm + ((wgid % nig) % gsz); u.pn = (wgid % nig) / gsz; return true;
    }
    __device__ __forceinline__ void a_ready(const Unit&) const {}
    __device__ __forceinline__ void done(const Unit&) const {}
};

typedef unsigned u32x2 __attribute__((ext_vector_type(2)));
typedef float f32x2_t __attribute__((ext_vector_type(2))); typedef __bf16 bf16x2_t __attribute__((ext_vector_type(2)));
__device__ __forceinline__ unsigned cvtpk(float lo, float hi) { f32x2_t v = {lo, hi}; bf16x2_t b = __builtin_convertvector(v, bf16x2_t); return __builtin_bit_cast(unsigned, b); }
__device__ __forceinline__ u32x4 pack8(f32x4 a, f32x4 b) { u32x4 w; w.x = cvtpk(a[0], a[1]); w.y = cvtpk(a[2], a[3]); w.z = cvtpk(b[0], b[1]); w.w = cvtpk(b[2], b[3]); return w; }
constexpr float RMS_EPS = 1e-5f;
constexpr float QSCALE = 0.125f * 1.4426950408889634f;
__device__ __forceinline__ float rscale_row(const float* rss, int row, int fq, int lane) {
    const f32x4 v = *(const f32x4*)(rss + (size_t)row * 16 + 4 * fq);
    float s = (v[0] + v[1]) + (v[2] + v[3]);
    s += lx_get(s, lane, 16); s = lx_sum32(s);
    return __builtin_amdgcn_rsqf(s * (1.0f / 1024.0f) + RMS_EPS);
}
struct EpiIn {
    static constexpr bool PERM = true, AFTER_DRAIN = false;
    const float* rss; const float* cosT; const float* sinT; bf16_t* Q; bf16_t* K; bf16_t* V; bf16_t* P;
    __device__ __forceinline__ void operator()(const f32x4 (&acc)[2][2][4][2], const Unit& u, int wr, int wc, int fr, int fq) const {
        const int pn = u.pn, lane = fq * 16 + fr; bf16_t* dst; int ld, colt;
        if (pn < 2) { dst = Q; ld = 512; colt = pn * 256; } else if (pn < 4) { dst = K; ld = 512; colt = (pn - 2) * 256; }
        else if (pn < 6) { dst = V; ld = 512; colt = (pn - 4) * 256; } else { dst = P; ld = 1792; colt = (pn - 6) * 256; }
        const bool qk = pn < 4; const bool rot = qk && ((wc & 1) == 0) && (fq < 2);
        const int col0 = colt + wc * 32 + 8 * fq;
#pragma unroll
        for (int ai = 0; ai < 2; ++ai)
#pragma unroll
            for (int m = 0; m < 4; ++m) {
                const int row = u.pm * BM + ai * HALF + wr * 64 + m * 16 + fr;
                const float rs = rscale_row(rss, row, fq, lane);
                f32x4 c0 = {1.f, 1.f, 1.f, 1.f}, c1 = c0, s0 = {0.f, 0.f, 0.f, 0.f}, s1 = s0;
                if (qk) { c0 = *(const f32x4*)(cosT + (size_t)row * 8); c1 = *(const f32x4*)(cosT + (size_t)row * 8 + 4); s0 = *(const f32x4*)(sinT + (size_t)row * 8); s1 = *(const f32x4*)(sinT + (size_t)row * 8 + 4); }
#pragma unroll
                for (int bj = 0; bj < 2; ++bj) {
                    f32x4 v0 = acc[ai][bj][m][0] * rs, v1 = acc[ai][bj][m][1] * rs;
                    if (qk) {
                        f32x4 p0, p1;
#pragma unroll
                        for (int j = 0; j < 4; ++j) { p0[j] = lx_get(v0[j], lane, 16); p1[j] = lx_get(v1[j], lane, 16); }
                        if (rot) { if (fq == 0) { v0 = v0 * c0 - p0 * s0; v1 = v1 * c1 - p1 * s1; } else { v0 = v0 * c0 + p0 * s0; v1 = v1 * c1 + p1 * s1; } }
                    }
                    if (pn < 2) { v0 = v0 * QSCALE; v1 = v1 * QSCALE; }
                    *(u32x4*)(dst + (size_t)row * ld + col0 + bj * HALF) = pack8(v0, v1);
                }
                asm volatile("" ::: "memory");
            }
    }
};
struct EpiRes {
    static constexpr bool PERM = true, AFTER_DRAIN = false;
    bf16_t* xb; float* rss;
    __device__ __forceinline__ void operator()(const f32x4 (&acc)[2][2][4][2], const Unit& u, int wr, int wc, int fr, int fq) const {
        const int col0 = u.pn * BM + wc * 32 + 8 * fq, lane = fq * 16 + fr;
        u32x4 rb[2][2];
#define RES_LD(gi, buf) do { const size_t off_ = (size_t)(u.pm * BM + ((gi) >> 2) * HALF + wr * 64 + ((gi) & 3) * 16 + fr) * 1024 + col0; \
        rb[buf][0] = *(const u32x4*)(xb + off_); rb[buf][1] = *(const u32x4*)(xb + off_ + HALF); } while (0)
        RES_LD(0, 0);
#pragma unroll
        for (int gi = 0; gi < 8; ++gi) {
            const int ai = gi >> 2, m = gi & 3, buf = gi & 1;
            if (gi < 7) RES_LD(gi + 1, buf ^ 1);
            asm volatile("" ::: "memory");
            const int row = u.pm * BM + ai * HALF + wr * 64 + m * 16 + fr; float ss = 0.f;
#pragma unroll
            for (int bj = 0; bj < 2; ++bj) {
                const u32x4 r = rb[buf][bj];
                const f32x4 b0 = {__uint_as_float(r.x << 16), __uint_as_float(r.x & 0xffff0000u), __uint_as_float(r.y << 16), __uint_as_float(r.y & 0xffff0000u)};
                const f32x4 b1 = {__uint_as_float(r.z << 16), __uint_as_float(r.z & 0xffff0000u), __uint_as_float(r.w << 16), __uint_as_float(r.w & 0xffff0000u)};
                const f32x4 v0 = b0 + acc[ai][bj][m][0], v1 = b1 + acc[ai][bj][m][1];
                ss += (v0[0] * v0[0] + v0[1] * v0[1]) + (v0[2] * v0[2] + v0[3] * v0[3]) + (v1[0] * v1[0] + v1[1] * v1[1]) + (v1[2] * v1[2] + v1[3] * v1[3]);
                *(u32x4*)(xb + (size_t)row * 1024 + col0 + bj * HALF) = pack8(v0, v1);
            }
            ss += lx_get(ss, lane, 16); ss = lx_sum32(ss);
            if (fq == 0) rss[(size_t)row * 16 + 4 * u.pn + wc] = ss;
            asm volatile("" ::: "memory");
        }
#undef RES_LD
    }
};
struct EpiUpConv {
    static constexpr bool PERM = true, AFTER_DRAIN = false;
    const float* rss; const float* cw; const float* cb; bf16_t* A2; PG8_LAS float* wbuf; PG8_LAS float* cbuf;
    __device__ __forceinline__ static float unpk(unsigned w, int hi) { float r; if (hi) asm volatile("v_and_b32 %0, 0xffff0000, %1" : "=v"(r) : "v"(w)); else asm volatile("v_lshlrev_b32 %0, 16, %1" : "=v"(r) : "v"(w)); return r; }
    __device__ __forceinline__ static float unpk2(unsigned w, int hi) { return __builtin_bit_cast(float, hi ? (w & 0xffff0000u) : (w << 16)); }
    __device__ __forceinline__ static void xch8(const unsigned (&w)[8], unsigned csm4, unsigned (&pv)[8], unsigned (&nx)[8]) {
        asm volatile("ds_write_b32 %0, %1 offset:4\n\tds_write_b32 %0, %2 offset:68\n\tds_write_b32 %0, %3 offset:132\n\tds_write_b32 %0, %4 offset:196\n\t"
                     "ds_write_b32 %0, %5 offset:260\n\tds_write_b32 %0, %6 offset:324\n\tds_write_b32 %0, %7 offset:388\n\tds_write_b32 %0, %8 offset:452"
                     :: "v"(csm4), "v"(w[0]), "v"(w[1]), "v"(w[2]), "v"(w[3]), "v"(w[4]), "v"(w[5]), "v"(w[6]), "v"(w[7]));
        asm volatile("ds_read_b32 %0, %16\n\tds_read_b32 %1, %16 offset:64\n\tds_read_b32 %2, %16 offset:128\n\tds_read_b32 %3, %16 offset:192\n\t"
                     "ds_read_b32 %4, %16 offset:256\n\tds_read_b32 %5, %16 offset:320\n\tds_read_b32 %6, %16 offset:384\n\tds_read_b32 %7, %16 offset:448\n\t"
                     "ds_read_b32 %8, %16 offset:8\n\tds_read_b32 %9, %16 offset:72\n\tds_read_b32 %10, %16 offset:136\n\tds_read_b32 %11, %16 offset:200\n\t"
                     "ds_read_b32 %12, %16 offset:264\n\tds_read_b32 %13, %16 offset:328\n\tds_read_b32 %14, %16 offset:392\n\tds_read_b32 %15, %16 offset:456\n\t"
                     "s_waitcnt lgkmcnt(0)"
                     : "=&v"(pv[0]), "=&v"(pv[1]), "=&v"(pv[2]), "=&v"(pv[3]), "=&v"(pv[4]), "=&v"(pv[5]), "=&v"(pv[6]), "=&v"(pv[7]),
                       "=&v"(nx[0]), "=&v"(nx[1]), "=&v"(nx[2]), "=&v"(nx[3]), "=&v"(nx[4]), "=&v"(nx[5]), "=&v"(nx[6]), "=&v"(nx[7])
                     : "v"(csm4));
    }
    __device__ __forceinline__ void operator()(const f32x4 (&acc)[2][2][4][2], const Unit& u, int wr, int wc, int fr, int fq) const {
        const int b = u.pm / 17, it = u.pm % 17, s0 = 252 * it + 126 * wr - 1;
        const int colb = u.pn * 128 + wc * 32 + 8 * fq;
        const int lane = fq * 16 + fr;
        PG8_LAS float* wb = wbuf + (wr * 4 + wc) * 256;
        const unsigned cs = (unsigned)(size_t)(cbuf + (wr * 4 + wc) * 512 + fq * 128 + fr) - 4u;
        { const int gu = lane >> 5, c = lane & 31; const float* src = cw + gu * 2816 + u.pn * 128 + wc * 32 + c;
            const f32x4 t = {src[0], src[5632], src[2 * 5632], cb[gu * 2816 + u.pn * 128 + wc * 32 + c]}; *(PG8_LAS f32x4*)(wb + 4 * lane) = t; }
        float rs[8];
#pragma unroll
        for (int g = 0; g < 8; ++g) { const int s = s0 + 16 * g + fr; const bool ok = (s >= 0) && (s < 4096); const int row = b * 4096 + (ok ? s : 0);
            const float r = rscale_row(rss, row, fq, lane); rs[g] = ok ? r : 0.f; }
#define PIN8(x) asm volatile("" : "+v"(x[0]), "+v"(x[1]), "+v"(x[2]), "+v"(x[3]), "+v"(x[4]), "+v"(x[5]), "+v"(x[6]), "+v"(x[7]))
        unsigned pk[8][2][2][2];
#pragma unroll
        for (int g = 0; g < 8; ++g)
#pragma unroll
            for (int bj = 0; bj < 2; ++bj)
#pragma unroll
                for (int n = 0; n < 2; ++n) { const f32x4 x = acc[g >> 2][bj][g & 3][n] * rs[g]; pk[g][bj][n][0] = cvtpk(x[0], x[1]); pk[g][bj][n][1] = cvtpk(x[2], x[3]); }
#pragma unroll
        for (int n = 0; n < 2; ++n) {
            unsigned res[8][2];
#pragma unroll
            for (int qp = 0; qp < 2; ++qp) {
                float gate[2][8];
                { unsigned w[8], pv[8], nx[8];
#pragma unroll
                    for (int g = 0; g < 8; ++g) w[g] = pk[g][0][n][qp];
                    xch8(w, cs, pv, nx);
#pragma unroll
                    for (int qq = 0; qq < 2; ++qq) { const f32x4 t = *(const PG8_LAS f32x4*)(wb + 4 * (8 * fq + 4 * n + 2 * qp + qq));
                        f32x2_t o[4], e[4];
#pragma unroll
                        for (int gp = 0; gp < 4; ++gp) { const f32x2_t a = {unpk2(w[2 * gp], qq), unpk2(w[2 * gp + 1], qq)}, pp = {unpk2(pv[2 * gp], qq), unpk2(pv[2 * gp + 1], qq)}, xx = {unpk2(nx[2 * gp], qq), unpk2(nx[2 * gp + 1], qq)};
                            o[gp] = ((f32x2_t){t[3], t[3]} + (f32x2_t){t[1], t[1]} * a) + (f32x2_t){t[0], t[0]} * pp + (f32x2_t){t[2], t[2]} * xx; }
#pragma unroll
                        for (int gp = 0; gp < 4; ++gp) { const f32x2_t z = o[gp] * -1.4426950408889634f; e[gp].x = __builtin_amdgcn_exp2f(z.x); e[gp].y = __builtin_amdgcn_exp2f(z.y); }
#pragma unroll
                        for (int gp = 0; gp < 4; ++gp) { const f32x2_t d = e[gp] + 1.0f; f32x2_t r; r.x = __builtin_amdgcn_rcpf(d.x); r.y = __builtin_amdgcn_rcpf(d.y); const f32x2_t gg = o[gp] * r; gate[qq][2 * gp] = gg.x; gate[qq][2 * gp + 1] = gg.y; }
                        PIN8(gate[qq]); } }
                { unsigned w[8], pv[8], nx[8];
#pragma unroll
                    for (int g = 0; g < 8; ++g) w[g] = pk[g][1][n][qp];
                    xch8(w, cs, pv, nx);
#pragma unroll
                    for (int qq = 0; qq < 2; ++qq) { const f32x4 t = *(const PG8_LAS f32x4*)(wb + 4 * (32 + 8 * fq + 4 * n + 2 * qp + qq));
#pragma unroll
                        for (int gp = 0; gp < 4; ++gp) { const f32x2_t a = {unpk2(w[2 * gp], qq), unpk2(w[2 * gp + 1], qq)}, pp = {unpk2(pv[2 * gp], qq), unpk2(pv[2 * gp + 1], qq)}, xx = {unpk2(nx[2 * gp], qq), unpk2(nx[2 * gp + 1], qq)};
                            const f32x2_t o = ((f32x2_t){t[3], t[3]} + (f32x2_t){t[1], t[1]} * a) + (f32x2_t){t[0], t[0]} * pp + (f32x2_t){t[2], t[2]} * xx;
                            const f32x2_t gg = (f32x2_t){gate[qq][2 * gp], gate[qq][2 * gp + 1]} * o; gate[qq][2 * gp] = gg.x; gate[qq][2 * gp + 1] = gg.y; }
                        PIN8(gate[qq]); } }
#pragma unroll
                for (int g = 0; g < 8; ++g) res[g][qp] = cvtpk(gate[0][g], gate[1][g]);
            }
#pragma unroll
            for (int g = 0; g < 8; ++g) { const int j = 16 * g + fr, s = s0 + j;
                if (j >= 1 && j <= 126 && s < 4096) { u32x2 w = {res[g][0], res[g][1]}; *(u32x2*)(A2 + (size_t)(b * 4096 + s) * 2816 + colb + 4 * n) = w; } }
        }
#undef PIN8
        asm volatile("s_waitcnt lgkmcnt(0)" ::: "memory");
    }
};
template <class Epi, class Sched, bool ALIGN_EPI = false, bool SP2 = false, int AMODE = 0>
__device__ __forceinline__ void gemm_phase(PG8_LAS unsigned char* lds, const Gemm g, const Sched& S, const Epi& E, int wave0) {
    unsigned mk_ = ~0u; asm volatile("" : "+s"(mk_)); int tid_raw = (int)__builtin_amdgcn_mbcnt_hi(mk_, __builtin_amdgcn_mbcnt_lo(mk_, 0u)); asm volatile("" : "+v"(tid_raw)); tid_raw += wave0 * 64; const int tid = tid_raw, wid = __builtin_amdgcn_readfirstlane(tid >> 6), lane = tid & 63, wr = wid >> 2, wc = wid & 3, fr = lane & 15, fq = lane >> 4;
    const int K = g.K, nt = K / BK;
    unsigned voffA[2], voffB[2];
#pragma unroll
    for (int i = 0; i < 2; ++i) { int R, C; stage_rc(tid * 16 + i * 8192, R, C); const int Rb = Epi::PERM ? ((R & ~31) + perm32(R & 31)) : R;
        const int Ra = AMODE ? ((R & 63) + 126 * (R >> 6)) : R; voffA[i] = (unsigned)(Ra * K + C) * 2u; voffB[i] = (unsigned)(Rb * K + C) * 2u; }
    const size_t kstep = (size_t)(BK * 2);
    const size_t hstep = (size_t)HALF * K * 2;
    const size_t tstep = 2 * hstep;
    const size_t hstepA = AMODE ? (size_t)64 * K * 2 : hstep;
#define PG8_ABASE(pm_) (AMODE ? (const char*)g.A + ((long)(((pm_) / 17) * 4096 + 252 * ((pm_) % 17) - 1)) * (long)K * 2 : (const char*)g.A + (size_t)(pm_) * tstep)
    const unsigned ldsw = (unsigned)wid * 1024u;
    const int aoff = lds_byte(wr * 64 + fr, fq * 8), boff = lds_byte(wc * 32 + fr, fq * 8);
#define PG8_SA(b, h) (((b) * 2 + (h)) * HTB)
#define PG8_SB(b, h) ((4 + (b) * 2 + (h)) * HTB)
#define PG8_STAGE(bufoff, gbase, voff) do { _Pragma("unroll") for (int _i = 0; _i < 2; ++_i) \
        __builtin_amdgcn_global_load_lds((const unsigned*)((const char*)(gbase) + (voff)[_i]), (PG8_LAS unsigned*)(lds + (bufoff) + ldsw + _i * 8192), 16, 0, 0); } while (0)
#define PG8_LDA(dst, b, h) do { _Pragma("unroll") for (int m = 0; m < 4; ++m) _Pragma("unroll") for (int k = 0; k < 2; ++k) dst[m][k] = *(const PG8_LAS bf16x8*)(lds + PG8_SA(b, h) + aoff + m * 2048 + k * 1024); } while (0)
#define PG8_LDB(dst, b, h) do { _Pragma("unroll") for (int n = 0; n < 2; ++n) _Pragma("unroll") for (int k = 0; k < 2; ++k) dst[n][k] = *(const PG8_LAS bf16x8*)(lds + PG8_SB(b, h) + boff + n * 2048 + k * 1024); } while (0)
#define PG8_MMA(ai, bj, At, Bt) do { __builtin_amdgcn_s_setprio(1); _Pragma("unroll") for (int m = 0; m < 4; ++m) _Pragma("unroll") for (int n = 0; n < 2; ++n) _Pragma("unroll") for (int k = 0; k < 2; ++k) \
        acc[ai][bj][m][n] = __builtin_amdgcn_mfma_f32_16x16x32_bf16(Bt[n][k], At[m][k], acc[ai][bj][m][n], 0, 0, 0); __builtin_amdgcn_s_setprio(0); } while (0)
#define PG8_WAIT_V(n) asm volatile("s_waitcnt vmcnt(" #n ")" ::: "memory")
#define PG8_WAIT_L(n) asm volatile("s_waitcnt lgkmcnt(" #n ")" ::: "memory")
#define PG8_BAR __builtin_amdgcn_s_barrier()
#define PG8_SCHED __builtin_amdgcn_sched_barrier(0)
    Unit cur, nxt; int ui = 0;
    if (!S.next(0, cur)) return;
    f32x4 acc[2][2][4][2];
#pragma unroll
    for (int a = 0; a < 2; ++a)
#pragma unroll
        for (int b = 0; b < 2; ++b)
#pragma unroll
            for (int m = 0; m < 4; ++m)
#pragma unroll
                for (int n = 0; n < 2; ++n) acc[a][b][m][n] = (f32x4){0.f, 0.f, 0.f, 0.f};
    bf16x8 At[4][2], B0[2][2], B1[2][2];
    const char* cA = PG8_ABASE(cur.pm); const char* cB = (const char*)g.Bt + (size_t)cur.pn * tstep;
    S.a_ready(cur);
    if constexpr (SP2) {
        PG8_STAGE(PG8_SB(0, 0), cB, voffB); PG8_STAGE(PG8_SB(0, 1), cB + hstep, voffB); PG8_STAGE(PG8_SA(0, 0), cA, voffA); PG8_STAGE(PG8_SA(0, 1), cA + hstepA, voffA);
        if (wr == 1) PG8_BAR;
        PG8_WAIT_V(2); PG8_BAR;
        PG8_STAGE(PG8_SB(1, 0), cB + kstep, voffB); PG8_STAGE(PG8_SA(1, 0), cA + kstep, voffA); PG8_STAGE(PG8_SB(1, 1), cB + hstep + kstep, voffB);
        PG8_WAIT_V(6); PG8_BAR;
    } else {
        PG8_STAGE(PG8_SB(0, 0), cB, voffB); PG8_STAGE(PG8_SA(0, 0), cA, voffA); PG8_STAGE(PG8_SB(0, 1), cB + hstep, voffB); PG8_STAGE(PG8_SA(0, 1), cA + hstepA, voffA);
        if (wr == 1) PG8_BAR;
        PG8_WAIT_V(4); PG8_BAR;
        PG8_STAGE(PG8_SB(1, 0), cB + kstep, voffB); PG8_STAGE(PG8_SA(1, 0), cA + kstep, voffA); PG8_STAGE(PG8_SB(1, 1), cB + hstep + kstep, voffB);
        PG8_WAIT_V(6); PG8_BAR;
    }
    for (;;) {
        const bool has_next = S.next(ui + 1, nxt);
        const char* nA = has_next ? PG8_ABASE(nxt.pm) : cA; const char* nB = has_next ? (const char*)g.Bt + (size_t)nxt.pn * tstep : cB;
        for (int t = 0; t < nt; t += 2) {
            const bool last = (t == nt - 2);
            const char* a1 = cA + (size_t)(t + 1) * kstep;
            const char* a2 = last ? nA : cA + (size_t)(t + 2) * kstep; const char* b2 = last ? nB : cB + (size_t)(t + 2) * kstep;
            const char* a3 = a2 + kstep; const char* b3 = b2 + kstep;
            if (last && has_next) S.a_ready(nxt);
            if constexpr (SP2) {
            PG8_LDB(B0, 0, 0); PG8_LDB(B1, 0, 1); PG8_SCHED; PG8_LDA(At, 0, 0); PG8_STAGE(PG8_SA(1, 1), a1 + hstepA, voffA);
            PG8_WAIT_V(8); PG8_WAIT_L(0); PG8_BAR; PG8_MMA(0, 0, At, B0); PG8_MMA(0, 1, At, B1); PG8_BAR; PG8_SCHED;
            PG8_LDA(At, 0, 1); PG8_STAGE(PG8_SB(0, 0), b2, voffB); PG8_STAGE(PG8_SB(0, 1), b2 + hstep, voffB); PG8_STAGE(PG8_SA(0, 0), a2, voffA);
            PG8_WAIT_V(8); PG8_WAIT_L(0); PG8_BAR; PG8_MMA(1, 0, At, B0); PG8_MMA(1, 1, At, B1); PG8_BAR; PG8_SCHED;
            PG8_LDB(B0, 1, 0); PG8_LDB(B1, 1, 1); PG8_SCHED; PG8_LDA(At, 1, 0); PG8_STAGE(PG8_SA(0, 1), a2 + hstepA, voffA);
            PG8_WAIT_V(8); PG8_WAIT_L(0); PG8_BAR; PG8_MMA(0, 0, At, B0); PG8_MMA(0, 1, At, B1); PG8_BAR; PG8_SCHED;
            PG8_LDA(At, 1, 1); PG8_STAGE(PG8_SB(1, 0), b3, voffB); PG8_STAGE(PG8_SB(1, 1), b3 + hstep, voffB); PG8_STAGE(PG8_SA(1, 0), a3, voffA);
            PG8_WAIT_V(8); PG8_WAIT_L(0); PG8_BAR; PG8_MMA(1, 0, At, B0); PG8_MMA(1, 1, At, B1); PG8_BAR; PG8_SCHED;
            } else {
            PG8_LDB(B0, 0, 0); PG8_SCHED; PG8_LDA(At, 0, 0); PG8_STAGE(PG8_SA(1, 1), a1 + hstepA, voffA);
            PG8_WAIT_L(8); PG8_BAR; PG8_WAIT_L(0); PG8_MMA(0, 0, At, B0); PG8_BAR; PG8_SCHED;
            PG8_LDB(B1, 0, 1); PG8_STAGE(PG8_SB(0, 0), b2, voffB);
            PG8_BAR; PG8_WAIT_L(0); PG8_MMA(0, 1, At, B1); PG8_BAR;
            PG8_LDA(At, 0, 1); PG8_STAGE(PG8_SA(0, 0), a2, voffA);
            PG8_BAR; PG8_WAIT_L(0); PG8_MMA(1, 0, At, B0); PG8_BAR; PG8_SCHED;
            PG8_STAGE(PG8_SB(0, 1), b2 + hstep, voffB);
            PG8_WAIT_V(6); PG8_BAR; PG8_MMA(1, 1, At, B1); PG8_BAR;
            PG8_LDB(B0, 1, 0); PG8_SCHED; PG8_LDA(At, 1, 0); PG8_STAGE(PG8_SA(0, 1), a2 + hstepA, voffA);
            PG8_WAIT_L(8); PG8_BAR; PG8_WAIT_L(0); PG8_MMA(0, 0, At, B0); PG8_BAR; PG8_SCHED;
            PG8_LDB(B1, 1, 1); PG8_STAGE(PG8_SB(1, 0), b3, voffB);
            PG8_BAR; PG8_WAIT_L(0); PG8_MMA(0, 1, At, B1); PG8_BAR;
            PG8_LDA(At, 1, 1); PG8_STAGE(PG8_SA(1, 0), a3, voffA);
            PG8_BAR; PG8_WAIT_L(0); PG8_MMA(1, 0, At, B0); PG8_BAR; PG8_SCHED;
            PG8_STAGE(PG8_SB(1, 1), b3 + hstep, voffB);
            PG8_WAIT_V(6); PG8_BAR; PG8_MMA(1, 1, At, B1); PG8_BAR;
            }
        }
        if constexpr (ALIGN_EPI) { if (wr == 0) PG8_BAR; }
        if constexpr (!Epi::AFTER_DRAIN) { E(acc, cur, wr, wc, fr, fq); S.done(cur); }
        if (!has_next) break;
#pragma unroll
        for (int a = 0; a < 2; ++a)
#pragma unroll
            for (int b = 0; b < 2; ++b)
#pragma unroll
                for (int m = 0; m < 4; ++m)
#pragma unroll
                    for (int n = 0; n < 2; ++n) acc[a][b][m][n] = (f32x4){0.f, 0.f, 0.f, 0.f};
        cur = nxt; cA = nA; cB = nB; ++ui;
        if constexpr (ALIGN_EPI) { if (wr == 1) PG8_BAR; }
    }
    PG8_WAIT_V(0);
    if constexpr (!ALIGN_EPI) { if (wr == 0) PG8_BAR; }
    PG8_BAR;
    if constexpr (Epi::AFTER_DRAIN) { E.fused(acc, cur, wr, wc, fr, fq, lds, wid, lane); S.done(cur); }
#undef PG8_SA
#undef PG8_ABASE
#undef PG8_SB
#undef PG8_STAGE
#undef PG8_LDA
#undef PG8_LDB
#undef PG8_MMA
#undef PG8_WAIT_V
#undef PG8_WAIT_L
#undef PG8_BAR
#undef PG8_SCHED
}
}
namespace attn {
using bf16x8 = __attribute__((ext_vector_type(8))) short;
using s16x4  = __attribute__((ext_vector_type(4))) short;
using f32x16 = __attribute__((ext_vector_type(16))) float;
using f32x4  = __attribute__((ext_vector_type(4))) float;
using u32x4  = __attribute__((ext_vector_type(4))) unsigned;
typedef unsigned short bf16_t;
constexpr int NW = 8, QBLK = 32, KVBLK = 64, LDQ = 512, LDK = 512, SEQ = 4096, LDY = 1024;
#define SBAR() __builtin_amdgcn_sched_barrier(0)
__device__ __forceinline__ int crow(int r, int hi) { return (r & 3) + 8 * (r >> 2) + 4 * hi; }
typedef float f32x2_t __attribute__((ext_vector_type(2))); typedef __bf16 bf16x2_t __attribute__((ext_vector_type(2)));
__device__ __forceinline__ unsigned cvtpk(float lo, float hi) { f32x2_t v = {lo, hi}; bf16x2_t b = __builtin_convertvector(v, bf16x2_t); return __builtin_bit_cast(unsigned, b); }

__device__ __forceinline__ int v_rd_base(int lane) { return ((lane & 3) << 3) | (((lane >> 2) & 3) << 6) | (((lane >> 4) & 1) << 5) | (((lane >> 5) & 1) << 8); }
constexpr int v_rd_off(int d0, int ks, int half) { return d0 * 512 + ks * 4096 + half * 2048; }
template <int OFF> __device__ __forceinline__ s16x4 tr_read(int vb) {
  s16x4 r; asm volatile("ds_read_b64_tr_b16 %0, %1 offset:%2" : "=&v"(r) : "v"(vb), "i"(OFF) : "memory"); return r;
}
constexpr int A2_K = 0, A2_V = 32768, A2_Q = 81920, A2_WS = 147456, A2_OB = 0;
typedef __attribute__((address_space(3))) char lchar;
typedef __attribute__((address_space(3))) unsigned luint;
#define GLDS16(gp, lp) __builtin_amdgcn_global_load_lds((const unsigned*)(gp), (luint*)(lp), 16, 0, 0)
__device__ __forceinline__ void glds16_so(const void* sbase, unsigned voff, unsigned lds_dst) {
  unsigned keep; asm volatile("s_nop 4\n\ts_mov_b32 %0, m0\n\ts_mov_b32 m0, %3\n\ts_nop 0\n\tglobal_load_lds_dwordx4 %1, %2\n\ts_mov_b32 m0, %0" : "=&s"(keep) : "v"(voff), "s"(sbase), "s"(lds_dst) : "memory"); }
template <int D0> __device__ __forceinline__ void pv2_one(f32x16& oa, f32x16& ob, int vb, const bf16x8 (&pa)[4], const bf16x8 (&pb)[4]) {
#define PK(L, H) (bf16x8){L[0], L[1], L[2], L[3], H[0], H[1], H[2], H[3]}
  { const s16x4 l0 = tr_read<v_rd_off(D0, 0, 0)>(vb), h0 = tr_read<v_rd_off(D0, 0, 1)>(vb), l1 = tr_read<v_rd_off(D0, 1, 0)>(vb), h1 = tr_read<v_rd_off(D0, 1, 1)>(vb);
    asm volatile("s_waitcnt lgkmcnt(0)" ::: "memory"); SBAR();
    const bf16x8 v0 = PK(l0, h0), v1 = PK(l1, h1);
    __builtin_amdgcn_s_setprio(1);
    oa = __builtin_amdgcn_mfma_f32_32x32x16_bf16(pa[0], v0, oa, 0, 0, 0); ob = __builtin_amdgcn_mfma_f32_32x32x16_bf16(pb[0], v0, ob, 0, 0, 0);
    oa = __builtin_amdgcn_mfma_f32_32x32x16_bf16(pa[1], v1, oa, 0, 0, 0); ob = __builtin_amdgcn_mfma_f32_32x32x16_bf16(pb[1], v1, ob, 0, 0, 0); __builtin_amdgcn_s_setprio(0); }
  { const s16x4 l2 = tr_read<v_rd_off(D0, 2, 0)>(vb), h2 = tr_read<v_rd_off(D0, 2, 1)>(vb), l3 = tr_read<v_rd_off(D0, 3, 0)>(vb), h3 = tr_read<v_rd_off(D0, 3, 1)>(vb);
    asm volatile("s_waitcnt lgkmcnt(0)" ::: "memory"); SBAR();
    const bf16x8 v2 = PK(l2, h2), v3 = PK(l3, h3);
    __builtin_amdgcn_s_setprio(1);
    oa = __builtin_amdgcn_mfma_f32_32x32x16_bf16(pa[2], v2, oa, 0, 0, 0); ob = __builtin_amdgcn_mfma_f32_32x32x16_bf16(pb[2], v2, ob, 0, 0, 0);
    oa = __builtin_amdgcn_mfma_f32_32x32x16_bf16(pa[3], v3, oa, 0, 0, 0); ob = __builtin_amdgcn_mfma_f32_32x32x16_bf16(pb[3], v3, ob, 0, 0, 0); __builtin_amdgcn_s_setprio(0); }
#undef PK
}
__device__ __forceinline__ void pv2(f32x16 (&oa)[4], f32x16 (&ob)[4], int vb, const bf16x8 (&pa)[4], const bf16x8 (&pb)[4]) {
  pv2_one<0>(oa[0], ob[0], vb, pa, pb); pv2_one<1>(oa[1], ob[1], vb, pa, pb); pv2_one<2>(oa[2], ob[2], vb, pa, pb); pv2_one<3>(oa[3], ob[3], vb, pa, pb);
}
template <int D0A, int D0B> __device__ __forceinline__ void qk_load(const lchar* Ks, int koff, int comp, bf16x8 (&k0)[4], bf16x8 (&k1)[4]) {
  typedef __attribute__((address_space(3))) bf16x8 lfrag;
#pragma unroll
  for (int d0 = D0A; d0 < D0B; ++d0) { const int off = (koff & ~0xF0) | ((koff ^ ((comp * 8 + d0 * 2) << 4)) & 0xF0);
    k0[d0] = *(const lfrag*)(Ks + off); k1[d0] = *(const lfrag*)(Ks + off + 8192); }
}
__device__ __forceinline__ void qk_mma(const bf16x8 (&q)[4], const bf16x8 (&k0)[4], const bf16x8 (&k1)[4], f32x16& p0, f32x16& p1) {
  p0 = __builtin_amdgcn_mfma_f32_32x32x16_bf16(k0[0], q[0], f32x16{}, 0, 0, 0); p1 = __builtin_amdgcn_mfma_f32_32x32x16_bf16(k1[0], q[0], f32x16{}, 0, 0, 0);
#pragma unroll
  for (int d0 = 1; d0 < 4; ++d0) { p0 = __builtin_amdgcn_mfma_f32_32x32x16_bf16(k0[d0], q[d0], p0, 0, 0, 0); p1 = __builtin_amdgcn_mfma_f32_32x32x16_bf16(k1[d0], q[d0], p1, 0, 0, 0); }
}
__device__ __forceinline__ void sm_part(f32x16& p0, f32x16& p1, float mref, bool use_ref, float& l_reg, bf16x8 (&pa)[4]) {
#define PK4(P, BASE, OUT) do { u32x4 w = {cvtpk(P[BASE + 0], P[BASE + 1]), cvtpk(P[BASE + 2], P[BASE + 3]), cvtpk(P[BASE + 4], P[BASE + 5]), cvtpk(P[BASE + 6], P[BASE + 7])}; \
    OUT = *reinterpret_cast<bf16x8*>(&w); } while (0)
  if (use_ref) {
    float m_ = mref; asm volatile("" : "+v"(m_));
#pragma unroll
    for (int r = 0; r < 16; ++r) { p0[r] -= m_; p1[r] -= m_; } }
  { float ps[4] = {0.f, 0.f, 0.f, 0.f};
#pragma unroll
    for (int r = 0; r < 16; ++r) { p0[r] = __builtin_amdgcn_exp2f(p0[r]); ps[r & 3] += p0[r]; }
    l_reg += (ps[0] + ps[1]) + (ps[2] + ps[3]); asm volatile("" : "+v"(l_reg));
    PK4(p0, 0, pa[0]); PK4(p0, 8, pa[1]); }
  { float ps[4] = {0.f, 0.f, 0.f, 0.f};
#pragma unroll
    for (int r = 0; r < 16; ++r) { p1[r] = __builtin_amdgcn_exp2f(p1[r]); ps[r & 3] += p1[r]; }
    l_reg += (ps[0] + ps[1]) + (ps[2] + ps[3]); asm volatile("" : "+v"(l_reg));
    PK4(p1, 0, pa[2]); PK4(p1, 8, pa[3]); }
#undef PK4
  asm volatile("" : "+v"(pa[0]), "+v"(pa[1]), "+v"(pa[2]), "+v"(pa[3]));
}
__device__ __forceinline__ void attn_unit2(const bf16_t* __restrict__ Qg, const bf16_t* __restrict__ Kg, const bf16_t* __restrict__ Vg, bf16_t* __restrict__ Yg,
                                           int b, int h, int q0, float lam, float lam_init, const float* __restrict__ subg, const unsigned* __restrict__ kmax2, lchar* lds, int wave0) {
  unsigned mk_ = ~0u; asm volatile("" : "+s"(mk_)); int tid_raw = (int)__builtin_amdgcn_mbcnt_hi(mk_, __builtin_amdgcn_mbcnt_lo(mk_, 0u)); asm volatile("" : "+v"(tid_raw)); tid_raw += wave0 * 64; const int tid = tid_raw, wid = __builtin_amdgcn_readfirstlane(tid >> 6), lane = tid & 63, r32 = lane & 31, hi = lane >> 5;
  const bool grpB = wid >= 4;
  const long rowbase = (long)b * SEQ;
  const bf16_t* Kh = Kg + rowbase * LDK + h * 128; const bf16_t* Vh = Vg + rowbase * LDK + h * 128;
  unsigned koffs[2], voffs[2];
#pragma unroll
  for (int ii = 0; ii < 2; ++ii) { const int s = 64 * (2 * wid + ii) + lane; const int row = s >> 4, ch = (s & 15) ^ (row & 15); koffs[ii] = (unsigned)(row * LDK + ch * 8) * 2u;
    const int st = s >> 5, kk = (st >> 2) * 8 + ((s >> 2) & 7), k = kk  , c8 = (st & 3) * 4 + (s & 3); voffs[ii] = (unsigned)(k * LDK + c8 * 8) * 2u; }
  lchar* Qw = lds + A2_Q + wid * 8192; const unsigned ldsb = (unsigned)(size_t)lds;
  { const bf16_t* Qrow = Qg + (rowbase + q0 + wid * QBLK) * LDQ + h * 128;
#pragma unroll
    for (int i = 0; i < 8; ++i) { const int s = 64 * i + lane, row = s >> 4, ch = (s & 15) ^ (row & 15); GLDS16(Qrow + row * LDQ + ch * 8, Qw + i * 1024); } }
#define DMA_KV(t, sk, sv) do { const char* kt_ = (const char*)(Kh + (long)(t) * KVBLK * LDK); const char* vt_ = (const char*)(Vh + (long)(t) * KVBLK * LDK); \
    _Pragma("unroll") for (int ii = 0; ii < 2; ++ii) { glds16_so(kt_, koffs[ii], ldsb + A2_K + (sk) * 16384 + (2 * wid + ii) * 1024); \
    glds16_so(vt_, voffs[ii], ldsb + A2_V + (sv) * 16384 + (2 * wid + ii) * 1024); } } while (0)
  DMA_KV(0, 0, 0);
  const int koff = r32 * 256 + (((hi) ^ (r32 & 15)) << 4);
  const int vb0 = (int)(size_t)(lds + A2_V) + v_rd_base(lane);
  float l1 = 0.f, l2 = 0.f, mref1, mref2; f32x16 o1[4] = {}, o2[4] = {}; bf16x8 pa1[4], pa2[4];
  asm volatile("s_waitcnt vmcnt(0)" ::: "memory");
  bf16x8 qf1[4], qf2[4];
  { float qa = 0.f, qb = 0.f;
#pragma unroll
    for (int d0 = 0; d0 < 4; ++d0) { const int off = (koff & ~0xF0) | ((koff ^ ((d0 * 2) << 4)) & 0xF0);
      const bf16x8 x = *(const __attribute__((address_space(3))) bf16x8*)(Qw + off), y = *(const __attribute__((address_space(3))) bf16x8*)(Qw + (off ^ 0x80)); qf1[d0] = x; qf2[d0] = y;
#pragma unroll
      for (int j = 0; j < 8; ++j) { const float fx = __uint_as_float((unsigned)(unsigned short)x[j] << 16), fy = __uint_as_float((unsigned)(unsigned short)y[j] << 16); qa += fx * fx; qb += fy * fy; } }
    qa = lx_sum32(qa);
    qb = lx_sum32(qb);
    const float ka = __uint_as_float(kmax2[(b * 4 + h) * 2 + 0]), kb = __uint_as_float(kmax2[(b * 4 + h) * 2 + 1]);
    mref1 = fmaxf(__builtin_amdgcn_sqrtf(qa * ka) * 1.001f - 64.f, 0.f); mref2 = fmaxf(__builtin_amdgcn_sqrtf(qb * kb) * 1.001f - 64.f, 0.f); }
  const bool use_ref = __any((mref1 != 0.f) || (mref2 != 0.f));
  const int NT = SEQ / KVBLK; int sk = 0, sv = 0, svp = 0;
  for (int j = 0; j < NT; ++j) {
    asm volatile("s_waitcnt vmcnt(0) lgkmcnt(0)\n\ts_barrier" ::: "memory");
    const int skn = sk ^ 1, svn = (sv == 2) ? 0 : sv + 1;
    if (j + 1 < NT) DMA_KV(j + 1, skn, svn);
    { bf16x8 kA0[4], kA1[4], kB0[4], kB1[4]; f32x16 sa0, sa1, sb0, sb1;
      if (grpB && j > 0) pv2(o1, o2, vb0 + svp * 16384, pa1, pa2);
      qk_load<0, 4>(lds + A2_K + sk * 16384, koff, 0, kA0, kA1); SBAR();
      qk_mma(qf1, kA0, kA1, sa0, sa1);
      qk_load<0, 2>(lds + A2_K + sk * 16384, koff, 1, kB0, kB1); SBAR();
      sm_part(sa0, sa1, mref1, use_ref, l1, pa1);
      SBAR();
      qk_load<2, 4>(lds + A2_K + sk * 16384, koff, 1, kB0, kB1);
      qk_mma(qf2, kB0, kB1, sb0, sb1);
      __builtin_amdgcn_sched_group_barrier(0x8, 2, 0); __builtin_amdgcn_sched_group_barrier(0x100, 2, 0); __builtin_amdgcn_sched_group_barrier(0x8, 2, 0); __builtin_amdgcn_sched_group_barrier(0x100, 2, 0);
      __builtin_amdgcn_sched_group_barrier(0x8, 4, 0); SBAR();
      sm_part(sb0, sb1, mref2, use_ref, l2, pa2); }
    if (!grpB) pv2(o1, o2, vb0 + sv * 16384, pa1, pa2);
    svp = sv; sk = skn; sv = svn;
  }
  if (grpB) pv2(o1, o2, vb0 + svp * 16384, pa1, pa2);
#undef DMA_KV
  unsigned mk2_ = ~0u; asm volatile("" : "+s"(mk2_)); int lane_e = (int)__builtin_amdgcn_mbcnt_hi(mk2_, __builtin_amdgcn_mbcnt_lo(mk2_, 0u)); asm volatile("" : "+v"(lane_e));
  l1 = lx_sum32(l1);
  l2 = lx_sum32(l2);
  __attribute__((address_space(3))) float* wsf = (__attribute__((address_space(3))) float*)(lds + A2_WS) + wid * 64;
  const int r32e = lane_e & 31, hie = lane_e >> 5;
  const float* subg_e = subg; asm volatile("" : "+s"(subg_e));
  if (hie == 0) { wsf[r32e] = __builtin_amdgcn_rcpf(l1); wsf[32 + r32e] = lam * __builtin_amdgcn_rcpf(l2); }
  asm volatile("s_waitcnt vmcnt(0) lgkmcnt(0)\n\ts_barrier" ::: "memory");
  __attribute__((address_space(3))) float* OB = (__attribute__((address_space(3))) float*)(lds + A2_OB + wid * 16384);
#pragma unroll
  for (int r = 0; r < 16; ++r) { const int orow = crow(r, hie); const float ra = wsf[orow], rb = wsf[32 + orow];
#pragma unroll
    for (int d0 = 0; d0 < 4; ++d0) { const int col = d0 * 32 + r32e; OB[orow * 128 + ((((col >> 2) ^ (orow & 7)) << 2) | (col & 3))] = o1[d0][r] * ra - o2[d0][r] * rb; } }
  asm volatile("s_waitcnt lgkmcnt(0)" ::: "memory");
  { const int row = lane_e >> 1, half = lane_e & 1; float ss = 0.f;
#pragma unroll
    for (int i = 0; i < 16; ++i) { const f32x4 v = *(const __attribute__((address_space(3))) f32x4*)(OB + row * 128 + (((16 * half + i) ^ (row & 7)) << 2)); ss += (v[0] * v[0] + v[1] * v[1]) + (v[2] * v[2] + v[3] * v[3]); }
    ss += __builtin_bit_cast(float, __builtin_amdgcn_update_dpp(0, __builtin_bit_cast(int, ss), 0xB1, 0xf, 0xf, false));
    float li_ = lam_init; asm volatile("" : "+s"(li_));
    const float rstd = (1.0f - li_) * __builtin_amdgcn_rsqf(ss * (1.0f / 128.0f) + 1e-5f);
    bf16_t* yp = Yg + (rowbase + q0 + wid * QBLK + row) * LDY + h * 128 + half * 64;
#pragma unroll 2
    for (int i = 0; i < 8; ++i) { const f32x4 g0 = *(const f32x4*)(subg_e + half * 64 + 8 * i), g1 = *(const f32x4*)(subg_e + half * 64 + 8 * i + 4);
      const f32x4 va = *(const __attribute__((address_space(3))) f32x4*)(OB + row * 128 + (((16 * half + 2 * i) ^ (row & 7)) << 2)), vc = *(const __attribute__((address_space(3))) f32x4*)(OB + row * 128 + (((16 * half + 2 * i + 1) ^ (row & 7)) << 2));
      const f32x4 a = va * g0 * rstd, c = vc * g1 * rstd;
      u32x4 w = {cvtpk(a[0], a[1]), cvtpk(a[2], a[3]), cvtpk(c[0], c[1]), cvtpk(c[2], c[3])};
      *(u32x4*)(yp + 8 * i) = w; } }
  asm volatile("s_waitcnt vmcnt(0) lgkmcnt(0)\n\ts_barrier" ::: "memory");
}
#undef GLDS16
#undef SBAR
}
#define LAS __attribute__((address_space(3)))
#define XB_TMO      128
#define XB_XCNT(j)  (256  + 64 * (j))
#define XB_XSUB(j)  (1280 + 64 * (j))
#define XB_XGEN(j)  (2304 + 64 * (j))
#define XB_TOP      3328
#define XB_TOPGEN   3392
#define XCD_BAR_WORDS 3456
#define XB_SPIN_CAP (1u << 18)

__device__ __forceinline__ unsigned xb_ld(unsigned* p)              { asm volatile("" : "+v"(p)); return __hip_atomic_load(p, __ATOMIC_RELAXED, __HIP_MEMORY_SCOPE_AGENT); }
__device__ __forceinline__ unsigned xb_add(unsigned* p, unsigned v) { asm volatile("" : "+v"(p), "+v"(v)); return __hip_atomic_fetch_add(p, v, __ATOMIC_RELAXED, __HIP_MEMORY_SCOPE_AGENT); }
__device__ __forceinline__ unsigned xb_xcc_id() { return (unsigned)__builtin_amdgcn_s_getreg((3 << 11) | 20) & 0xFu; }
#define XB_SPIN(cond, bar) do { unsigned _sp = 0; while (cond) { __builtin_amdgcn_s_sleep(1); \
    if ((++_sp & 255u) == 0u) { if (xb_ld(&(bar)[XB_TMO])) break; if (_sp > XB_SPIN_CAP) { atomicAdd(&(bar)[XB_TMO], 1u); break; } } } } while (0)

__device__ __forceinline__ bool xb_lane0() { unsigned mk_ = ~0u; asm volatile("" : "+s"(mk_)); return __builtin_amdgcn_mbcnt_hi(mk_, __builtin_amdgcn_mbcnt_lo(mk_, 0u)) == 0u; }
struct XcdBarrier {
    int w0;
    unsigned* bar; unsigned x;
    volatile LAS unsigned* st;
};

__device__ __forceinline__ XcdBarrier xcd_barrier_post(unsigned* bar, volatile LAS unsigned* st, int w0) {
    XcdBarrier b; b.w0 = w0; b.bar = bar; b.x = xb_xcc_id(); b.st = st;
    if (b.w0 == 0 && xb_lane0()) (void)xb_add(&bar[XB_XCNT(b.x)], 1u);
    return b;
}
__device__ __forceinline__ void xcd_barrier_complete(unsigned* bar, unsigned x, unsigned& nloc, unsigned& nx) {
    const unsigned G = gridDim.x * gridDim.y * gridDim.z;
    unsigned sum, cnt, mine, sp = 0u;
    for (;;) {
        sum = 0u; cnt = 0u; mine = 0u;
#pragma unroll
        for (unsigned j = 0; j < 16; ++j) { const unsigned c = xb_ld(&bar[XB_XCNT(j)]); sum += c; cnt += (c > 0u) ? 1u : 0u; mine = (j == x) ? c : mine; }
        if (sum == G) break;
        __builtin_amdgcn_s_sleep(1);
        if ((++sp & 255u) == 0u) { if (xb_ld(&bar[XB_TMO])) break; if (sp > XB_SPIN_CAP) { atomicAdd(&bar[XB_TMO], 1u); break; } }
    }
    nloc = mine > 0u ? mine : 1u; nx = cnt > 0u ? cnt : 1u;
}

__device__ __forceinline__ void xcd_barrier(const XcdBarrier& b) {
    asm volatile("s_waitcnt vmcnt(0)" ::: "memory");
    __syncthreads();
    if (b.w0 == 0 && xb_lane0()) {
        unsigned* bar = b.bar;
        __builtin_amdgcn_s_waitcnt(0);
        unsigned nloc = b.st[0], nx = b.st[1];
        if (nloc == 0u) { xcd_barrier_complete(bar, b.x, nloc, nx); b.st[0] = nloc; b.st[1] = nx; }
        const unsigned old = xb_add(&bar[XB_XSUB(b.x)], 1u);
        const unsigned gen = old / nloc;
        if (old + 1u == (gen + 1u) * nloc) {
            __builtin_amdgcn_fence(__ATOMIC_RELEASE, "agent");
            asm volatile("s_waitcnt vmcnt(0)" ::: "memory");
            const unsigned og = xb_add(&bar[XB_TOP], 1u);
            const unsigned tg = og / nx;
            if (og + 1u == (tg + 1u) * nx) xb_add(&bar[XB_TOPGEN], 1u);
            else XB_SPIN(xb_ld(&bar[XB_TOPGEN]) == tg, bar);
            __builtin_amdgcn_fence(__ATOMIC_ACQUIRE, "agent");
            xb_add(&bar[XB_XGEN(b.x)], 1u);
            asm volatile("s_waitcnt vmcnt(0)" ::: "memory");
        } else {
            XB_SPIN(xb_ld(&bar[XB_XGEN(b.x)]) == gen, bar);
            __builtin_amdgcn_fence(__ATOMIC_ACQUIRE, "agent");
            asm volatile("s_waitcnt vmcnt(0)" ::: "memory");
        }
    }
    __syncthreads();
}
#undef LAS
#define LAS __attribute__((address_space(3)))
typedef unsigned short bf16;
typedef float f32x4 __attribute__((ext_vector_type(4)));
typedef float f32x16 __attribute__((ext_vector_type(16)));
typedef short bf16x8 __attribute__((ext_vector_type(8)));
typedef short s16x4 __attribute__((ext_vector_type(4)));
typedef unsigned u32x4 __attribute__((ext_vector_type(4)));
typedef unsigned u32x2 __attribute__((ext_vector_type(2)));
typedef short v4i16_t __attribute__((ext_vector_type(4)));

constexpr int NWAVES = 8, NTHREADS = 512;
constexpr int BATCH = 4, SEQ = 4096, D = 1024, DEPTH = 4, M = BATCH * SEQ;
constexpr int IN_COLS = 3336, IN_MAIN = 3328, DFF = 2816, UPW = 5632;
constexpr float LOG2E = 1.4426950408889634f;
constexpr int LDS_BYTES = 163840, LDSCTL_OFF = LDS_BYTES - 512;

constexpr size_t MiB = 1u << 20;
constexpr size_t WS_CTL = 0, CTL_ZERO_BYTES = 64 * 1024;
constexpr size_t WS_COS = 1 * MiB, WS_SIN = WS_COS + 512 * 1024, WS_RSS = 2 * MiB, WS_DT = 3 * MiB, WS_CD = WS_DT + 512 * 1024, WS_KMAX = WS_CD + 65536, WS_SSDV = 4 * MiB;
constexpr size_t WS_W0 = 8 * MiB, W_LAYER = 25 * MiB, WO_IN = 0, WO_OUT = 6815744, WO_UP = WO_OUT + 2 * MiB, WO_DOWN = WO_UP + 11 * MiB;
constexpr size_t WS_XG = 108 * MiB;
constexpr size_t WS_Q = 140 * MiB, WS_K = 156 * MiB, WS_V = 172 * MiB, WS_P = 188 * MiB, WS_XBC = 244 * MiB, WS_Y = 268 * MiB, WS_S = 300 * MiB;
constexpr size_t WS_A2 = 140 * MiB;
constexpr size_t WS_END = 332 * MiB;
static_assert(WO_DOWN + (size_t)D * DFF * 2 <= W_LAYER && WS_W0 + DEPTH * W_LAYER <= WS_XG && WS_A2 + (size_t)M * DFF * 2 <= WS_XBC && WS_S + (size_t)BATCH * 32 * 4 * 2 * 8192 * 4 <= WS_END, "ws map");
constexpr int CW_BAR = 1024;
constexpr int CW_SCAN = 8192;

struct Params { const float* in[23]; float* out; unsigned char* ws; int ph_lo, ph_hi; };
enum { I_X = 0, I_POS, I_NMG, I_WIN, I_LQ1, I_LK1, I_LQ2, I_LK2, I_SUBG, I_SCW, I_SSDW, I_SSDB, I_DTB, I_ALOG, I_SSDD, I_SSDNG, I_WOUT, I_NFG, I_WUP, I_FCW, I_FCB, I_WDOWN, I_FNG };

__device__ __forceinline__ float bf2f(unsigned short h) { return __uint_as_float((unsigned)h << 16); }
__device__ __forceinline__ float bflo(unsigned w) { return __uint_as_float(w << 16); }
__device__ __forceinline__ float bfhi(unsigned w) { return __uint_as_float(w & 0xffff0000u); }
__device__ __forceinline__ void unpack8(u32x4 w, float* f) { f[0] = bflo(w.x); f[1] = bfhi(w.x); f[2] = bflo(w.y); f[3] = bfhi(w.y); f[4] = bflo(w.z); f[5] = bfhi(w.z); f[6] = bflo(w.w); f[7] = bfhi(w.w); }
__device__ __forceinline__ unsigned cvtpk(float lo, float hi) { return pg8::cvtpk(lo, hi); }
__device__ __forceinline__ u32x4 pack8f(const float* f) { u32x4 w; w.x = cvtpk(f[0], f[1]); w.y = cvtpk(f[2], f[3]); w.z = cvtpk(f[4], f[5]); w.w = cvtpk(f[6], f[7]); return w; }
__device__ __forceinline__ float silu_f(float v) { return v * __builtin_amdgcn_rcpf(1.0f + __expf(-v)); }
__device__ __forceinline__ float softplus_f(float v) { return fmaxf(v, 0.f) + log1pf(__expf(-fabsf(v))); }
__device__ __forceinline__ int crow(int r, int hi) { return (r & 3) + 8 * (r >> 2) + 4 * hi; }

__device__ __forceinline__ bf16x8 frag_row(const LAS char* img, int pitch, int row0, int k0, int lane) {
    return *(const LAS bf16x8*)(img + (row0 + (lane & 31)) * pitch + (k0 + 8 * (lane >> 5)) * 2);
}
__device__ __forceinline__ s16x4 tr4(const LAS char* p) { return __builtin_bit_cast(s16x4, __builtin_amdgcn_ds_read_tr16_b64_v4i16((LAS v4i16_t*)p)); }
__device__ __forceinline__ bf16x8 frag_tr_std(const LAS char* img, int pitch, int x0, int k0, int lane) {
    const int g = lane >> 4, i = lane & 15; const LAS char* p = img + (k0 + 8 * (g >> 1) + (i >> 2)) * pitch + (x0 + 16 * (g & 1) + 4 * (i & 3)) * 2;
    const s16x4 lo = tr4(p), hi = tr4(p + 4 * pitch);
    return (bf16x8){lo[0], lo[1], lo[2], lo[3], hi[0], hi[1], hi[2], hi[3]};
}
__device__ __forceinline__ bf16x8 frag_tr_perm(const LAS char* img, int pitch, int x0, int k0, int lane) {
    const int g = lane >> 4, i = lane & 15; const LAS char* p = img + (k0 + 4 * (g >> 1) + (i >> 2)) * pitch + (x0 + 16 * (g & 1) + 4 * (i & 3)) * 2;
    const s16x4 lo = tr4(p), hi = tr4(p + 8 * pitch);
    return (bf16x8){lo[0], lo[1], lo[2], lo[3], hi[0], hi[1], hi[2], hi[3]};
}
#define MFMA32(a, b, c) __builtin_amdgcn_mfma_f32_32x32x16_bf16((a), (b), (c), 0, 0, 0)

__device__ __forceinline__ void transpose_item(const float* W, int ldN, int k0, int n0, bf16* WT, int K, int dest_row0, LAS float* scr, int lane, const float* gk = nullptr) {
    f32x4 v[8];
#pragma unroll
    for (int i = 0; i < 8; ++i) { const int kk = 8 * i + (lane >> 3); v[i] = __builtin_nontemporal_load((const f32x4*)(W + (size_t)(k0 + kk) * ldN + n0 + 4 * (lane & 7))); }
#pragma unroll
    for (int i = 0; i < 8; ++i) { const int kk = 8 * i + (lane >> 3); const float sc_ = gk ? gk[k0 + kk] : 1.0f; LAS float* d = scr + kk * 33 + 4 * (lane & 7);
        d[0] = sc_ * v[i][0]; d[1] = sc_ * v[i][1]; d[2] = sc_ * v[i][2]; d[3] = sc_ * v[i][3]; }
    asm volatile("s_waitcnt lgkmcnt(0)" ::: "memory");
    const int c = lane & 7;
#pragma unroll
    for (int j = 0; j < 4; ++j) { const int n = (lane >> 3) + 8 * j; const LAS float* s = scr + (8 * c) * 33 + n;
        u32x4 o; o.x = cvtpk(s[0 * 33], s[1 * 33]); o.y = cvtpk(s[2 * 33], s[3 * 33]); o.z = cvtpk(s[4 * 33], s[5 * 33]); o.w = cvtpk(s[6 * 33], s[7 * 33]);
        *(u32x4*)(WT + (size_t)(dest_row0 + n0 + n) * K + k0 + 8 * c) = o; }
    asm volatile("s_waitcnt lgkmcnt(0)" ::: "memory");
}
__device__ __forceinline__ void convert_layer(const Params& p, int layer, LAS unsigned char* lds, int gw, int NGW, int wave, int lane) {
    LAS float* scr = (LAS float*)(lds + wave * 16384);
    unsigned char* wl = p.ws + WS_W0 + (size_t)layer * W_LAYER; bf16* WIN = (bf16*)(wl + WO_IN); bf16* WOUT = (bf16*)(wl + WO_OUT); bf16* WUP = (bf16*)(wl + WO_UP); bf16* WDOWN = (bf16*)(wl + WO_DOWN);
    constexpr int I_IN = 16 * 104, I_OUT = 16 * 32, I_UP = 16 * 176, I_DOWN = 44 * 32, NITEMS = I_IN + I_OUT + I_UP + I_DOWN;
    for (int it = gw; it < NITEMS; it += NGW) {
        int r = it;
        if (r < I_IN) { const int kb = r / 104, nb = r % 104; transpose_item(p.in[I_WIN] + (size_t)layer * D * IN_COLS, IN_COLS, 64 * kb, 32 * nb, WIN, D, 0, scr, lane, p.in[I_NMG] + layer * D); continue; } r -= I_IN;
        if (r < I_OUT) { const int kb = r / 32, nb = r % 32; transpose_item(p.in[I_WOUT] + (size_t)layer * D * D, D, 64 * kb, 32 * nb, WOUT, D, 0, scr, lane); continue; } r -= I_OUT;
        if (r < I_UP) { const int kb = r / 176, nb = r % 176; const int n0 = 32 * nb; const int nn = n0 < DFF ? n0 : n0 - DFF; const int drow = (nn >> 7) * 256 + (n0 < DFF ? 0 : 128) + (nn & 127);
            transpose_item(p.in[I_WUP] + (size_t)layer * D * UPW, UPW, 64 * kb, n0, WUP, D, drow - n0, scr, lane, p.in[I_NFG] + layer * D); continue; } r -= I_UP;
        { const int kb = r / 32, nb = r % 32; transpose_item(p.in[I_WDOWN] + (size_t)layer * DFF * D, D, 64 * kb, 32 * nb, WDOWN, DFF, 0, scr, lane); }
    }
}
__device__ __forceinline__ float inv_freq(int j) {
    switch (j) { case 0: return 1.0f; case 1: return 0.19392274f; case 2: return 0.03760603f; case 3: return 0.0072926646f; case 4: return 0.0014142136f; case 5: return 0.0002742482f; case 6: return 5.3182957e-05f; default: return 1.0313385e-05f; }
}

__device__ __forceinline__ void ssd1_unit(const Params& p, int layer, int b, int c, int g, LAS unsigned char* lds, int wave0) {
    unsigned mk_ = ~0u; asm volatile("" : "+s"(mk_)); int tid_raw = (int)__builtin_amdgcn_mbcnt_hi(mk_, __builtin_amdgcn_mbcnt_lo(mk_, 0u)); asm volatile("" : "+v"(tid_raw)); tid_raw += wave0 * 64; const int tid = tid_raw, wid = __builtin_amdgcn_readfirstlane(tid >> 6), lane = tid & 63, r32 = lane & 31, hi = lane >> 5;
    const int t0 = b * SEQ + c * 128;
    LAS char* XWF = (LAS char*)lds; LAS char* XWB = XWF + 40960; LAS char* BC = XWF + 81920; LAS float* sc = (LAS float*)(lds + 122880);
    const bf16* __restrict__ P = (const bf16*)(p.ws + WS_P); bf16* __restrict__ XBC = (bf16*)(p.ws + WS_XBC); const float* DT = (const float*)(p.ws + WS_DT);
    float* SSDV = (float*)(p.ws + WS_SSDV); float* CD = (float*)(p.ws + WS_CD); float* S = (float*)(p.ws + WS_S);
    if (tid < 256) { const int hh = tid >> 7, l = tid & 127, h = 2 * g + hh, t = t0 + l;
        const float dtf = softplus_f(DT[t * 8 + h] + p.in[I_DTB][layer * 8 + h]), dtb = softplus_f(DT[t * 8 + 4 + h] + p.in[I_DTB][layer * 8 + 4 + h]);
        const float A0 = -__expf(p.in[I_ALOG][layer * 8 + h]), A1 = -__expf(p.in[I_ALOG][layer * 8 + 4 + h]);
        sc[0 * 256 + tid] = dtf * A0 * LOG2E; sc[1 * 256 + tid] = dtb * A1 * LOG2E; sc[2 * 256 + tid] = dtf; sc[3 * 256 + tid] = dtb; }
    __syncthreads();
    if (wid < 4) { const int hh = wid >> 1, dir = wid & 1; LAS float* a = sc + dir * 256 + hh * 128;
        const float e0 = a[2 * lane], e1 = a[2 * lane + 1], ps = e0 + e1; float inc = ps;
#pragma unroll
        for (int o = 1; o < 64; o <<= 1) { const float tt = __builtin_bit_cast(float, __builtin_amdgcn_ds_bpermute((lane - o) << 2, __builtin_bit_cast(int, inc))); if (lane >= o) inc += tt; }
        const float exc = inc - ps, c0 = exc + e0, c1 = exc + ps, tot = __builtin_bit_cast(float, __builtin_amdgcn_readlane(__builtin_bit_cast(int, inc), 63));
        if (dir == 0) { sc[6 * 256 + hh * 128 + 2 * lane] = c0; sc[6 * 256 + hh * 128 + 2 * lane + 1] = c1; }
        else { sc[7 * 256 + hh * 128 + 2 * lane] = tot - c0 + e0; sc[7 * 256 + hh * 128 + 2 * lane + 1] = tot - c1 + e1; } }
    __syncthreads();
    if (tid < 256) { const int hh = tid >> 7, l = tid & 127, h = 2 * g + hh, t = t0 + l;
        const float fc = sc[6 * 256 + tid], rc = sc[7 * 256 + tid], dtf = sc[2 * 256 + tid], dtb = sc[3 * 256 + tid];
        const float ftot = sc[6 * 256 + hh * 128 + 127], rtot = sc[7 * 256 + hh * 128];
        sc[4 * 256 + tid] = __builtin_amdgcn_exp2f(ftot - fc) * dtf; sc[5 * 256 + tid] = __builtin_amdgcn_exp2f(rtot - rc) * dtb;
        *(f32x4*)(SSDV + ((size_t)t * 4 + h) * 4) = (f32x4){fc, rc, dtf, dtb};
        if (l == 0) { CD[((b * 32 + c) * 4 + h) * 2 + 0] = __builtin_amdgcn_exp2f(ftot); CD[((b * 32 + c) * 4 + h) * 2 + 1] = __builtin_amdgcn_exp2f(rtot); } }
    __syncthreads();
    const float* cw = p.in[I_SSDW] + (size_t)layer * 3 * 768; const float* cb = p.in[I_SSDB] + (size_t)layer * 768;
    if (tid < 480) { const int cch = tid % 48, rb = tid / 48, seg = cch >> 4, cc = cch & 15, ch0 = seg * 256 + 128 * g + 8 * cc, l0 = 13 * rb;
        float w0[8], w1[8], w2[8], bb[8];
        *(f32x4*)&w0[0] = *(const f32x4*)(cw + ch0); *(f32x4*)&w0[4] = *(const f32x4*)(cw + ch0 + 4);
        *(f32x4*)&w1[0] = *(const f32x4*)(cw + 768 + ch0); *(f32x4*)&w1[4] = *(const f32x4*)(cw + 768 + ch0 + 4);
        *(f32x4*)&w2[0] = *(const f32x4*)(cw + 1536 + ch0); *(f32x4*)&w2[4] = *(const f32x4*)(cw + 1536 + ch0 + 4);
        *(f32x4*)&bb[0] = *(const f32x4*)(cb + ch0); *(f32x4*)&bb[4] = *(const f32x4*)(cb + ch0 + 4);
        const bf16* src0 = P + (size_t)(t0 + l0) * 1792 + 1024 + ch0;
        u32x4 rr[15];
#pragma unroll
        for (int k = 0; k < 15; ++k) { const int l = l0 + k - 1, s = c * 128 + l; rr[k] = (u32x4){0u, 0u, 0u, 0u};
            if (l <= 128 && s >= 0 && s < SEQ) rr[k] = *(const u32x4*)(src0 + (long)(k - 1) * 1792); }
        float xa[8], xb[8], xc[8]; unpack8(rr[0], xa); unpack8(rr[1], xb);
        const int hh = cc >> 3;
#pragma unroll
        for (int k = 0; k < 13; ++k) { const int l = l0 + k;
            unpack8(rr[k + 2], xc);
            if (l < 128) { float v[8];
#pragma unroll
                for (int j = 0; j < 8; ++j) v[j] = silu_f(bb[j] + w0[j] * xa[j] + w1[j] * xb[j] + w2[j] * xc[j]);
                *(u32x4*)(XBC + (size_t)(t0 + l) * 768 + ch0) = pack8f(v);
                if (seg == 0) { const float wf = sc[4 * 256 + hh * 128 + l], wb = sc[5 * 256 + hh * 128 + l]; float vf[8], vb[8];
#pragma unroll
                    for (int j = 0; j < 8; ++j) { vf[j] = v[j] * wf; vb[j] = v[j] * wb; }
                    *(LAS u32x4*)(XWF + l * 320 + cc * 16) = pack8f(vf); *(LAS u32x4*)(XWB + l * 320 + cc * 16) = pack8f(vb); }
                else if (seg == 1) { *(LAS u32x4*)(BC + l * 320 + cc * 16) = pack8f(v); } }
#pragma unroll
            for (int j = 0; j < 8; ++j) { xa[j] = xb[j]; xb[j] = xc[j]; } }
    }
    __syncthreads();
    { const int dir = wid >> 2, hh = (wid >> 1) & 1, pt = wid & 1, h = 2 * g + hh; const LAS char* img = dir ? XWB : XWF;
        f32x16 acc[4] = {};
#pragma unroll
        for (int kk = 0; kk < 8; ++kk) { const bf16x8 A = frag_tr_std(img, 320, 64 * hh + 32 * pt, 16 * kk, lane);
#pragma unroll
            for (int nt = 0; nt < 4; ++nt) { const bf16x8 B = frag_tr_std(BC, 320, 32 * nt, 16 * kk, lane); acc[nt] = MFMA32(A, B, acc[nt]); } }
        float* Sp = S + ((size_t)(((b * 32 + c) * 4 + h) * 2 + dir)) * 8192;
#pragma unroll
        for (int nt = 0; nt < 4; ++nt)
#pragma unroll
            for (int r = 0; r < 16; ++r) Sp[(32 * pt + crow(r, hi)) * 128 + 32 * nt + r32] = acc[nt][r];
    }
    __syncthreads();
}

__device__ __forceinline__ void ssd3_unit(const Params& p, int layer, int b, int c, int g, LAS unsigned char* lds, int wave0) {
    unsigned mk_ = ~0u; asm volatile("" : "+s"(mk_)); int tid_raw = (int)__builtin_amdgcn_mbcnt_hi(mk_, __builtin_amdgcn_mbcnt_lo(mk_, 0u)); asm volatile("" : "+v"(tid_raw)); tid_raw += wave0 * 64; const int tid = tid_raw, wid = __builtin_amdgcn_readfirstlane(tid >> 6), lane = tid & 63, r32 = lane & 31, hi = lane >> 5;
    const int t0 = b * SEQ + c * 128;
    LAS float* sc = (LAS float*)lds; LAS char* CI = (LAS char*)lds + 8192; LAS char* XS = CI + 34816; LAS char* BI = XS + 40960; LAS char* HI = BI;
    const bf16* P = (const bf16*)(p.ws + WS_P); const bf16* XBC = (const bf16*)(p.ws + WS_XBC); const float* SSDV = (const float*)(p.ws + WS_SSDV);
    const float* S = (const float*)(p.ws + WS_S); bf16* Y = (bf16*)(p.ws + WS_Y);
    f32x4 hreg[16];
    { const float* Sb = S + ((size_t)((b * 32 + c) * 4 + 2 * g) * 2) * 8192;
#pragma unroll
        for (int i = 0; i < 16; ++i) { const int idx = tid + NTHREADS * i; hreg[i] = *(const f32x4*)(Sb + (size_t)(idx >> 11) * 8192 + (idx & 2047) * 4); } }
#pragma unroll 6
    for (int it = tid; it < 128 * 48; it += NTHREADS) {
        const int l = it / 48, cch = it % 48, seg = cch >> 4, cc = cch & 15;
        const u32x4 v = *(const u32x4*)(XBC + (size_t)(t0 + l) * 768 + seg * 256 + 128 * g + 8 * cc);
        if (seg == 0) *(LAS u32x4*)(XS + l * 320 + cc * 16) = v; else if (seg == 1) *(LAS u32x4*)(BI + l * 272 + cc * 16) = v; else *(LAS u32x4*)(CI + l * 272 + cc * 16) = v;
    }
    if (tid < 256) { const int hh = tid >> 7, l = tid & 127, h = 2 * g + hh; const f32x4 sv = *(const f32x4*)(SSDV + ((size_t)(t0 + l) * 4 + h) * 4);
        sc[0 * 256 + tid] = sv[0]; sc[1 * 256 + tid] = sv[1]; sc[2 * 256 + tid] = sv[0] - __log2f(sv[2]); sc[3 * 256 + tid] = sv[1] - __log2f(sv[3]); }
    __syncthreads();
    const int lb = wid & 3, hh = wid >> 2, h = 2 * g + hh;
    f32x16 X[4] = {};
#pragma unroll
    for (int kk = 0; kk < 8; ++kk) { const bf16x8 Bf = frag_row(CI, 272, 32 * lb, 16 * kk, lane);
#pragma unroll
        for (int st = 0; st < 4; ++st) { const bf16x8 Af = frag_row(BI, 272, 32 * st, 16 * kk, lane); X[st] = MFMA32(Af, Bf, X[st]); } }
    __syncthreads();
    {
#pragma unroll
        for (int i = 0; i < 16; ++i) { const int idx = tid + NTHREADS * i, img = idx >> 11, e = (idx & 2047) * 4, pp = e >> 7, n = e & 127;
            u32x2 w; w.x = cvtpk(hreg[i][0], hreg[i][1]); w.y = cvtpk(hreg[i][2], hreg[i][3]);
            *(LAS u32x2*)(HI + img * 17408 + pp * 272 + n * 2) = w; } }
    __syncthreads();
    const int l = 32 * lb + r32; const float fl = sc[0 * 256 + hh * 128 + l], rl = sc[1 * 256 + hh * 128 + l]; const float Dh = p.in[I_SSDD][layer * 4 + h];
    f32x16 y[2] = {};
#pragma unroll
    for (int st = 0; st < 4; ++st) {
        bf16x8 wfr[2];
#pragma unroll
        for (int ss = 0; ss < 2; ++ss) { unsigned w[4];
#pragma unroll
            for (int jj = 0; jj < 4; ++jj) { float val[2];
#pragma unroll
                for (int q = 0; q < 2; ++q) { const int r = 8 * ss + 2 * jj + q, s = 32 * st + crow(r, hi);
                    const float ef = sc[2 * 256 + hh * 128 + s], eb = sc[3 * 256 + hh * 128 + s];
                    const float f1 = __builtin_amdgcn_exp2f(fl - ef), f2 = __builtin_amdgcn_exp2f(rl - eb);
                    const float fac = (s <= l ? f1 : 0.f) + (s >= l ? f2 : 0.f);
                    val[q] = X[st][r] * fac + (s == l ? Dh : 0.f); }
                w[jj] = cvtpk(val[0], val[1]); }
            const u32x4 ww = {w[0], w[1], w[2], w[3]}; wfr[ss] = __builtin_bit_cast(bf16x8, ww); }
#pragma unroll
        for (int ss = 0; ss < 2; ++ss)
#pragma unroll
            for (int pt = 0; pt < 2; ++pt) { const bf16x8 Af = frag_tr_perm(XS, 320, 64 * hh + 32 * pt, 32 * st + 16 * ss, lane); y[pt] = MFMA32(Af, wfr[ss], y[pt]); }
    }
#pragma unroll
    for (int dir = 0; dir < 2; ++dir) { f32x16 yo[2] = {};
#pragma unroll
        for (int kk = 0; kk < 8; ++kk) { const bf16x8 Bf = frag_row(CI, 272, 32 * lb, 16 * kk, lane);
#pragma unroll
            for (int pt = 0; pt < 2; ++pt) { const bf16x8 Af = frag_row(HI + (hh * 2 + dir) * 17408, 272, 32 * pt, 16 * kk, lane); yo[pt] = MFMA32(Af, Bf, yo[pt]); } }
        const float el = __builtin_amdgcn_exp2f(dir ? rl : fl);
#pragma unroll
        for (int pt = 0; pt < 2; ++pt)
#pragma unroll
            for (int r = 0; r < 16; ++r) y[pt][r] += el * yo[pt][r];
    }
    const size_t t = (size_t)t0 + l; float ssq = 0.f;
#pragma unroll
    for (int pt = 0; pt < 2; ++pt)
#pragma unroll
        for (int q4 = 0; q4 < 4; ++q4) { const int pp = 32 * pt + 8 * q4 + 4 * hi; const u32x2 zz = *(const u32x2*)(P + t * 1792 + 768 + 128 * g + 64 * hh + pp);
            const float z0 = bflo(zz.x), z1 = bfhi(zz.x), z2 = bflo(zz.y), z3 = bfhi(zz.y);
            y[pt][4 * q4 + 0] *= silu_f(z0); y[pt][4 * q4 + 1] *= silu_f(z1); y[pt][4 * q4 + 2] *= silu_f(z2); y[pt][4 * q4 + 3] *= silu_f(z3);
#pragma unroll
            for (int q = 0; q < 4; ++q) ssq += y[pt][4 * q4 + q] * y[pt][4 * q4 + q]; }
    ssq = lx_sum32(ssq);
    if (hi == 0) sc[4 * 256 + hh * 128 + l] = ssq;
    __syncthreads();
    const float tot = sc[4 * 256 + l] + sc[4 * 256 + 128 + l]; const float rstd = __builtin_amdgcn_rsqf(tot * (1.0f / 128.0f) + 1e-5f);
    const float* ng = p.in[I_SSDNG] + layer * 256 + 128 * g + 64 * hh;
#pragma unroll
    for (int pt = 0; pt < 2; ++pt)
#pragma unroll
        for (int q4 = 0; q4 < 4; ++q4) { const int pp = 32 * pt + 8 * q4 + 4 * hi; const f32x4 gg = *(const f32x4*)(ng + pp);
            u32x2 w; w.x = cvtpk(y[pt][4 * q4 + 0] * rstd * gg[0], y[pt][4 * q4 + 1] * rstd * gg[1]); w.y = cvtpk(y[pt][4 * q4 + 2] * rstd * gg[2], y[pt][4 * q4 + 3] * rstd * gg[3]);
            *(u32x2*)(Y + t * 1024 + 768 + 128 * g + 64 * hh + pp) = w; }
    __syncthreads();
}
#ifndef PHASE_MASK
#define PHASE_MASK 0xFFFF
#endif
#define PEN(i) ((PHASE_MASK >> (i)) & 1)
#ifndef REP_CVT
#define REP_CVT 1
#endif
#ifndef REP_IN
#define REP_IN 1
#endif
#ifndef REP_MIXA
#define REP_MIXA 1
#endif
#ifndef REP_ATT
#define REP_ATT 1
#endif
#ifndef REP_MIXC
#define REP_MIXC 1
#endif
#ifndef REP_UP
#define REP_UP 1
#endif
constexpr int PH_PRO = 0, PH_PER_LAYER = 7, PH_FINAL = 1 + PH_PER_LAYER * DEPTH, NPH = PH_FINAL + 1;
enum { LP_IN = 0, LP_MIXA, LP_MIXB, LP_MIXC, LP_OUT, LP_UP, LP_DOWN };

__global__ void __launch_bounds__(NTHREADS, 2) fwd_kernel(Params p) {
    extern __shared__ __attribute__((aligned(16))) unsigned char lds_raw[];
    LAS unsigned char* lds = (LAS unsigned char*)lds_raw;
    const int G = gridDim.x, bx = blockIdx.x, vcu = (G % 8 == 0) ? (bx % 8) * (G / 8) + bx / 8 : bx;
    const int NGW = G * NWAVES, NGT = G * NTHREADS;
    const int wave0 = __builtin_amdgcn_readfirstlane(threadIdx.x >> 6);
#define LOCALS unsigned mk_ = ~0u; asm volatile("" : "+s"(mk_)); int tid_r = (int)__builtin_amdgcn_mbcnt_hi(mk_, __builtin_amdgcn_mbcnt_lo(mk_, 0u)); asm volatile("" : "+v"(tid_r)); tid_r += wave0 * 64; const int tid = tid_r, lane = tid & 63, wave = __builtin_amdgcn_readfirstlane(tid >> 6), gw = vcu * NWAVES + wave, gtid = vcu * NTHREADS + tid; (void)lane; (void)gw; (void)gtid;
    volatile LAS unsigned* MISC = (volatile LAS unsigned*)(lds + LDSCTL_OFF);
    { LOCALS for (int u = tid; u < (LDS_BYTES - LDSCTL_OFF) / 4; u += NTHREADS) ((LAS unsigned*)(lds + LDSCTL_OFF))[u] = 0u; }
    __syncthreads();
    unsigned* ctl = (unsigned*)(p.ws + WS_CTL);
    const bool multi = (p.ph_hi - p.ph_lo) > 1;
    XcdBarrier bar; bar.w0 = wave0; bar.bar = ctl + CW_BAR; bar.x = 0; bar.st = nullptr;
    if (multi) bar = xcd_barrier_post(ctl + CW_BAR, MISC + 8, wave0);
#define IN(k) (p.ph_lo <= (k) && (k) < p.ph_hi)
#define SEAM(k) do { if (p.ph_lo <= (k) && (k) + 1 < p.ph_hi) xcd_barrier(bar); } while (0)

#define XO (p.out)
#define XG ((bf16*)(p.ws + WS_XG))
#define RSS ((float*)(p.ws + WS_RSS))
#define COS ((float*)(p.ws + WS_COS))
#define SIN ((float*)(p.ws + WS_SIN))
#define Qb ((bf16*)(p.ws + WS_Q))
#define Kb ((bf16*)(p.ws + WS_K))
#define Vb ((bf16*)(p.ws + WS_V))
#define Pb ((bf16*)(p.ws + WS_P))
#define Yb ((bf16*)(p.ws + WS_Y))
#define DT ((float*)(p.ws + WS_DT))
#define A2 ((bf16*)(p.ws + WS_A2))
#define WIN ((bf16*)(p.ws + WS_W0 + (size_t)layer * W_LAYER + WO_IN))
#define WOUT ((bf16*)(p.ws + WS_W0 + (size_t)layer * W_LAYER + WO_OUT))
#define WUP ((bf16*)(p.ws + WS_W0 + (size_t)layer * W_LAYER + WO_UP))
#define WDOWN ((bf16*)(p.ws + WS_W0 + (size_t)layer * W_LAYER + WO_DOWN))

    if (PEN(0) && IN(PH_PRO)) { LOCALS
        const int* pos = (const int*)p.in[I_POS];
        for (int i = gtid; i < M * 8; i += NGT) { const int row = i >> 3, j = i & 7; const float ang = (float)pos[row] * inv_freq(j);
            const double rev = (double)ang * 0.15915494309189535; const double fr = rev - __builtin_rint(rev); const float a = (float)(fr * 6.283185307179586);
            COS[i] = cosf(a); SIN[i] = sinf(a); }
        for (int rep = 0; rep < REP_CVT; ++rep) convert_layer(p, 0, lds, gw, NGW, wave, lane);
        __syncthreads();
        for (int m = gw; m < M; m += NGW) { const f32x4* xr = (const f32x4*)(p.in[I_X] + (size_t)m * D) + lane; float ss = 0.f; u32x2* o8 = (u32x2*)(XG + (size_t)m * D) + lane;
#pragma unroll
            for (int j = 0; j < 4; ++j) { const f32x4 v = xr[64 * j]; ss += (v[0] * v[0] + v[1] * v[1]) + (v[2] * v[2] + v[3] * v[3]);
                u32x2 w; w.x = cvtpk(v[0], v[1]); w.y = cvtpk(v[2], v[3]); o8[64 * j] = w; }
            ss = wave_sum(ss); if (lane < 16) RSS[(size_t)m * 16 + lane] = lane == 0 ? ss : 0.f; }
    }
    if (multi && p.ph_lo <= PH_PRO && PH_PRO + 1 < p.ph_hi) cg::this_grid().sync();

    for (int layer = 0; layer < DEPTH; ++layer) {
        const int pb = 1 + PH_PER_LAYER * layer;
        const float lam_init = layer == 0 ? 0.2f : layer == 1 ? 0.35550906759f : layer == 2 ? 0.47071301834f : 0.55605820416f;
        if (PEN(2) && IN(pb + LP_IN)) {
            { LOCALS
            if (bx == 0 && tid < 32) ((unsigned*)(p.ws + WS_KMAX))[tid] = 0u;
            {
                const float* wsrc = p.in[I_WIN] + (size_t)layer * D * IN_COLS + IN_MAIN; float w[16][8];
#pragma unroll
                for (int i = 0; i < 16; ++i) { const float gk_ = p.in[I_NMG][layer * D + 16 * lane + i]; const f32x4 a = *(const f32x4*)(wsrc + (size_t)(16 * lane + i) * IN_COLS) * gk_, b = *(const f32x4*)(wsrc + (size_t)(16 * lane + i) * IN_COLS + 4) * gk_;
                    w[i][0] = a[0]; w[i][1] = a[1]; w[i][2] = a[2]; w[i][3] = a[3]; w[i][4] = b[0]; w[i][5] = b[1]; w[i][6] = b[2]; w[i][7] = b[3]; }
                for (int m = gw; m < M; m += NGW) { const u32x4 a = *(const u32x4*)(XG + (size_t)m * D + 16 * lane), b = *(const u32x4*)(XG + (size_t)m * D + 16 * lane + 8);
                    float xv[16]; unpack8(a, xv); unpack8(b, xv + 8); float acc[8];
#pragma unroll
                    for (int j = 0; j < 8; ++j) acc[j] = 0.f;
#pragma unroll
                    for (int i = 0; i < 16; ++i)
#pragma unroll
                        for (int j = 0; j < 8; ++j) acc[j] += xv[i] * w[i][j];
                    float s = lane < 16 ? RSS[(size_t)m * 16 + lane] : 0.f; s = wave_sum(s); const float rs = __builtin_amdgcn_rsqf(s * (1.0f / 1024.0f) + 1e-5f);
                    float outv = 0.f;
#pragma unroll
                    for (int j = 0; j < 8; ++j) { const float t = wave_sum(acc[j]); if (lane == j) outv = t; }
                    if (lane < 8) DT[(size_t)m * 8 + lane] = outv * rs; }
            } }
            pg8::Gemm g{XG, WIN, M, IN_MAIN, D}; pg8::StaticOrder S; S.init(M, IN_MAIN, G, bx);
            pg8::EpiIn E{RSS, COS, SIN, Qb, Kb, Vb, Pb};
            const int nfull = (64 * 13) % G, nidle = G - nfull;
            if (layer + 1 < DEPTH && nidle > 0 && nfull > 0) { if (bx >= nfull) { LOCALS convert_layer(p, layer + 1, lds, (bx - nfull) * NWAVES + wave, nidle * NWAVES, wave, lane); } __syncthreads(); }
            for (int rep = 0; rep < REP_IN; ++rep) pg8::gemm_phase<pg8::EpiIn, pg8::StaticOrder, true, true>(lds, g, S, E, wave0);
            if (layer + 1 < DEPTH && !(nidle > 0 && nfull > 0)) { { LOCALS convert_layer(p, layer + 1, lds, gw, NGW, wave, lane); } __syncthreads(); }
        }
        SEAM(pb + LP_IN);
        if (PEN(3) && IN(pb + LP_MIXA)) { LOCALS
            {
                unsigned* KMAX = (unsigned*)(p.ws + WS_KMAX); LAS float* red = (LAS float*)(lds + 155648);
                for (int i0 = vcu * NTHREADS; i0 < M * 8; i0 += NGT) { const int i = i0 + tid, t = i >> 3, hc = i & 7; const bf16* kp = Kb + (size_t)t * 512 + hc * 64; float ss = 0.f;
#pragma unroll
                    for (int j = 0; j < 8; ++j) { float f[8]; unpack8(*(const u32x4*)(kp + 8 * j), f);
#pragma unroll
                        for (int e = 0; e < 8; ++e) ss += f[e] * f[e]; }
                    ss = fmaxf(ss, lx_get(ss, lane, 8)); ss = fmaxf(ss, lx_get(ss, lane, 16)); ss = lx_max32(ss);
                    if (lane < 8) red[wave * 8 + lane] = ss;
                    __syncthreads();
                    if (tid < 8) { float m = red[tid];
#pragma unroll
                        for (int w = 1; w < 8; ++w) m = fmaxf(m, red[w * 8 + tid]);
                        atomicMax(KMAX + (i0 >> 15) * 8 + tid, __float_as_uint(m)); }
                    __syncthreads(); }
            }
            for (int rep = 0; rep < REP_MIXA; ++rep) for (int u = vcu; u < 256; u += G) ssd1_unit(p, layer, u >> 6, (u >> 1) & 31, u & 1, lds, wave0);
            const float* scw = p.in[I_SCW] + (size_t)layer * 3 * 256;
            const bf16* __restrict__ Pr_ = Pb; bf16* __restrict__ Yr_ = Yb;
#pragma unroll 4
            for (int it = gtid; it < M * 32; it += NGT) { const int t = it >> 5, cc = it & 31, s = t & (SEQ - 1); const bf16* src = Pr_ + (size_t)t * 1792 + 8 * cc;
                float bv[8], c0[8], c1[8], c2[8], h0[8], h1[8], h2[8], o[8]; const u32x4 z4 = {0u, 0u, 0u, 0u};
                unpack8(*(const u32x4*)src, bv); unpack8(*(const u32x4*)(src + 256), c1); unpack8(*(const u32x4*)(src + 512), h1);
                unpack8(s > 0 ? *(const u32x4*)(src - 1792 + 256) : z4, c0); unpack8(s > 0 ? *(const u32x4*)(src - 1792 + 512) : z4, h0);
                unpack8(s < SEQ - 1 ? *(const u32x4*)(src + 1792 + 256) : z4, c2); unpack8(s < SEQ - 1 ? *(const u32x4*)(src + 1792 + 512) : z4, h2);
#pragma unroll
                for (int j = 0; j < 8; ++j) o[j] = bv[j] * (scw[8 * cc + j] * (c0[j] * h0[j]) + scw[256 + 8 * cc + j] * (c1[j] * h1[j]) + scw[512 + 8 * cc + j] * (c2[j] * h2[j]));
                *(u32x4*)(Yr_ + (size_t)t * 1024 + 512 + 8 * cc) = pack8f(o); }
        }
        SEAM(pb + LP_MIXA);
        if (PEN(4) && IN(pb + LP_MIXB)) {
            { LOCALS float* S = (float*)(p.ws + WS_S); const float* CD = (const float*)(p.ws + WS_CD);
                for (int i = gtid; i < 32 * 4096; i += NGT) { const int bhd = i >> 12, e = (i & 4095) * 2, b = bhd >> 3, h = (bhd >> 1) & 3, dir = bhd & 1;
                    typedef float f32x2_ __attribute__((ext_vector_type(2)));
                    f32x2_ st[32]; float dec[32]; const int cmask = dir ? 31 : 0;
#pragma unroll
                    for (int cc = 0; cc < 32; ++cc) { const int c = cc ^ cmask; st[cc] = *(const f32x2_*)(S + ((size_t)(((b * 32 + c) * 4 + h) * 2 + dir)) * 8192 + e); dec[cc] = CD[((b * 32 + c) * 4 + h) * 2 + dir]; }
                    float z0_ = 0.f; asm volatile("" : "+v"(z0_)); f32x2_ hs = {z0_, z0_};
#pragma unroll
                    for (int cc = 0; cc < 32; ++cc) { const int c = cc ^ cmask; *(f32x2_*)(S + ((size_t)(((b * 32 + c) * 4 + h) * 2 + dir)) * 8192 + e) = hs; hs = hs * dec[cc] + st[cc]; } } }
            asm volatile("s_waitcnt vmcnt(0)" ::: "memory");
            __syncthreads();
            if (multi && wave0 == 0 && xb_lane0()) { __builtin_amdgcn_fence(__ATOMIC_RELEASE, "agent"); asm volatile("s_waitcnt vmcnt(0)" ::: "memory"); (void)xb_add(ctl + CW_SCAN + layer, 1u); }
            float lam;
            { LOCALS const float a = wave_sum(p.in[I_LQ1][layer * 64 + lane] * p.in[I_LK1][layer * 64 + lane]), b2 = wave_sum(p.in[I_LQ2][layer * 64 + lane] * p.in[I_LK2][layer * 64 + lane]);
                lam = __builtin_bit_cast(float, __builtin_amdgcn_readfirstlane(__builtin_bit_cast(int, __expf(a) - __expf(b2) + lam_init))); }
#define ATT_UNIT(UID) do { const int uid_ = (UID), b = uid_ >> 6, h = (uid_ >> 4) & 3, qb = uid_ & 15; \
                attn::attn_unit2(Qb, Kb, Vb, Yb, b, h, qb * 256, lam, lam_init_s, p.in[I_SUBG] + layer * 128, (const unsigned*)(p.ws + WS_KMAX), (attn::lchar*)lds, wave0); } while (0)
            const float lam_init_s = __builtin_bit_cast(float, __builtin_amdgcn_readfirstlane(__builtin_bit_cast(int, lam_init)));
            for (int rep = 0; rep < REP_ATT; ++rep) {
                if (G >= 256) { if (vcu < 256) ATT_UNIT(vcu); }
                else for (int uid = vcu; uid < 256; uid += G) ATT_UNIT(uid); }
#undef ATT_UNIT
        }
        if (!multi) SEAM(pb + LP_MIXB);
        else if (IN(pb + LP_MIXB) && IN(pb + LP_MIXC)) {
            if (wave0 == 0 && xb_lane0()) { unsigned* sc_ = ctl + CW_SCAN + layer; XB_SPIN(xb_ld(sc_) < (unsigned)G, bar.bar); __builtin_amdgcn_fence(__ATOMIC_ACQUIRE, "agent"); asm volatile("s_waitcnt vmcnt(0)" ::: "memory"); }
            __syncthreads(); }
        if (PEN(5) && IN(pb + LP_MIXC)) { for (int rep = 0; rep < REP_MIXC; ++rep) for (int u = vcu; u < 256; u += G) ssd3_unit(p, layer, u >> 6, (u >> 1) & 31, u & 1, lds, wave0); }
        SEAM(pb + LP_MIXC);
        if (PEN(6) && IN(pb + LP_OUT)) {
            pg8::Gemm g{Yb, WOUT, M, D, D}; pg8::StaticOrder S; S.init(M, D, G, bx);
            pg8::EpiRes E{XG, RSS};
            pg8::gemm_phase<pg8::EpiRes, pg8::StaticOrder, true, true>(lds, g, S, E, wave0);
        }
        SEAM(pb + LP_OUT);
        if (PEN(7) && IN(pb + LP_UP)) {
            pg8::Gemm g{XG, WUP, 68 * 256, UPW, D}; pg8::StaticOrder S; S.init(68 * 256, UPW, G, bx);
            pg8::EpiUpConv E{RSS, p.in[I_FCW] + (size_t)layer * 3 * UPW, p.in[I_FCB] + (size_t)layer * UPW, A2, (LAS float*)(lds + 147456), (LAS float*)(lds + 131072)};
            for (int rep = 0; rep < REP_UP; ++rep) pg8::gemm_phase<pg8::EpiUpConv, pg8::StaticOrder, true, true, 1>(lds, g, S, E, wave0);
        }
        SEAM(pb + LP_UP);
        if (PEN(9) && IN(pb + LP_DOWN)) {
            pg8::Gemm g{A2, WDOWN, M, D, DFF}; pg8::StaticOrder S; S.init(M, D, G, bx);
            pg8::EpiRes E{XG, RSS};
            pg8::gemm_phase<pg8::EpiRes, pg8::StaticOrder, true, true>(lds, g, S, E, wave0);
        }
        SEAM(pb + LP_DOWN);
    }
    if (PEN(10) && IN(PH_FINAL)) { LOCALS
        const float* gf = p.in[I_FNG];
        for (int m = gw; m < M; m += NGW) { float s = lane < 16 ? RSS[(size_t)m * 16 + lane] : 0.f; s = wave_sum(s); const float rs = __builtin_amdgcn_rsqf(s * (1.0f / 1024.0f) + 1e-5f);
            const u32x2* xr = (const u32x2*)(XG + (size_t)m * D) + lane; f32x4* orow = (f32x4*)(XO + (size_t)m * D) + lane;
#pragma unroll
            for (int j = 0; j < 4; ++j) { const u32x2 w = xr[64 * j]; const f32x4 v = {bflo(w.x), bfhi(w.x), bflo(w.y), bfhi(w.y)}; const f32x4 gg = *((const f32x4*)gf + lane + 64 * j); orow[64 * j] = v * gg * rs; } }
    }
#undef IN
#undef SEAM
}

__global__ void fill_kernel(float* o, int n, float v) { for (int i = blockIdx.x * blockDim.x + threadIdx.x; i < n; i += gridDim.x * blockDim.x) o[i] = v; }

#ifndef N_LAUNCH_MODE
#define N_LAUNCH_MODE 1
#endif
extern "C" void kernel_launch(void* const* d_in, const int* in_sizes, int n_in, void* d_out, int out_size, void* d_ws, size_t ws_size, hipStream_t stream) {
    static int grid = 0;
    if (grid == 0) {
        if (n_in != 23 || in_sizes[0] != M * D || out_size != M * D || ws_size < WS_END) {
            fprintf(stderr, "kernel_launch: unexpected shapes / workspace: n_in %d in0 %d out %d ws %zu (need %zu)\n", n_in, n_in > 0 ? in_sizes[0] : -1, out_size, ws_size, (size_t)WS_END);
            grid = -1;
        } else {
            int dev = 0, cus = 0, per_cu = 0;
            hipGetDevice(&dev); hipDeviceGetAttribute(&cus, hipDeviceAttributeMultiprocessorCount, dev);
            hipFuncSetAttribute((const void*)fwd_kernel, hipFuncAttributeMaxDynamicSharedMemorySize, LDS_BYTES);
            hipOccupancyMaxActiveBlocksPerMultiprocessor(&per_cu, (const void*)fwd_kernel, NTHREADS, LDS_BYTES);
            (void)hipGetLastError();
            if (per_cu < 1) { fprintf(stderr, "kernel_launch: occupancy query reports %d blocks per CU\n", per_cu); grid = -1; }
            else grid = cus;
        }
    }
    if (grid < 0) { hipLaunchKernelGGL(fill_kernel, dim3(256), dim3(256), 0, stream, (float*)d_out, out_size, 1.0e30f); return; }
    hipMemsetAsync((char*)d_ws + WS_CTL, 0, CTL_ZERO_BYTES, stream);
    Params a{};
    for (int i = 0; i < 23; ++i) a.in[i] = (const float*)d_in[i];
    a.out = (float*)d_out; a.ws = (unsigned char*)d_ws;
#if N_LAUNCH_MODE == 0
    for (int ph = 0; ph < NPH; ++ph) { a.ph_lo = ph; a.ph_hi = ph + 1; hipLaunchKernelGGL(fwd_kernel, dim3(grid), dim3(NTHREADS), LDS_BYTES, stream, a); }
#else
    a.ph_lo = 0; a.ph_hi = NPH; void* args[] = {&a};
    hipError_t e = hipLaunchCooperativeKernel((const void*)fwd_kernel, dim3(grid), dim3(NTHREADS), args, LDS_BYTES, stream);
    if (e != hipSuccess) fprintf(stderr, "cooperative launch failed: %s (grid %d)\n", hipGetErrorString(e), grid);
#endif
}
```
